# Optimizing an MI355X kernel written in HIP

```python
import math
import jax, jax.numpy as jnp
from jax import lax
import numpy as np

D_MODEL = 2048
BATCH = 2
SEQ = 8192
DEPTH = 1

MEM_LEN = 256
D_FF = 256 * math.ceil(8 * D_MODEL / 3 / 256)
BRANCH_WIDTH = D_MODEL // 2
N_BRANCH = 3
CONV_WIDTH = BRANCH_WIDTH
CONV_K = 3
NSA_HEAD_DIM = 64
NSA_HEADS = BRANCH_WIDTH // NSA_HEAD_DIM
NSA_GROUPS = 4
NSA_HPG = NSA_HEADS // NSA_GROUPS
NSA_KV = NSA_GROUPS * NSA_HEAD_DIM
CMP_LEN = 32
CMP_STRIDE = 16
CMP_HIDDEN = 4 * NSA_HEAD_DIM
SLC_LEN = 64
SLC_TOP = 16
WIN = 512
Q_BLOCK = 128
MEM_HEADS = 4
MEM_HEAD_DIM = BRANCH_WIDTH // MEM_HEADS
EPS = 1e-6
NEG_INF = -1e30
FORCE_SCORE = 1e9
IN_SPLITS = (CONV_WIDTH, CONV_WIDTH, CONV_WIDTH,
             NSA_HEADS * NSA_HEAD_DIM,
             6 * NSA_KV,
             3 * NSA_HEADS,
             MEM_HEADS * MEM_HEAD_DIM,
             N_BRANCH * D_MODEL)
D_IN = sum(IN_SPLITS)

kernel_name = 'hybrid_conv_nsa_mem_macaron'


def rms_norm(x, g):
    xf = x.astype(jnp.float32)
    y = xf * lax.rsqrt(jnp.mean(xf * xf, axis=-1, keepdims=True) + EPS)
    return (y * g.astype(jnp.float32)).astype(x.dtype)


def swiglu(h, w_gate, w_up, w_down):
    return (jax.nn.silu(h @ w_gate) * (h @ w_up)) @ w_down


def masked_softmax(s, valid):
    s = jnp.where(valid, s.astype(jnp.float32), NEG_INF)
    p = jax.nn.softmax(s, axis=-1)
    return jnp.where(valid, p, 0.0)


def short_conv_mixer(b, c, u, conv_w):
    z = c * u
    y = lax.conv_general_dilated(z, conv_w[:, None, :], window_strides=(1,),
                                 padding=[(CONV_K - 1, 0)],
                                 dimension_numbers=('NWC', 'WIO', 'NWC'),
                                 feature_group_count=CONV_WIDTH)
    return b * y


def compress_blocks(t, pe, w1, w2):
    B, S = t.shape[:2]
    n_c = (S - CMP_LEN) // CMP_STRIDE + 1
    idx = jnp.arange(n_c)[:, None] * CMP_STRIDE + jnp.arange(CMP_LEN)[None, :]
    blk = t[:, idx] + pe[None, None, :, None, :]
    blk = jnp.moveaxis(blk, 3, 2).reshape(B, n_c, NSA_GROUPS, CMP_LEN * NSA_HEAD_DIM)
    return jax.nn.silu(blk @ w1) @ w2


def selection_map(n_c, n_s):
    ratio = SLC_LEN // CMP_STRIDE
    offs = np.arange(-(CMP_LEN // CMP_STRIDE - 1), ratio)
    ci = ratio * np.arange(n_s)[:, None] + offs[None, :]
    cs = ci * CMP_STRIDE
    ss = np.arange(n_s)[:, None] * SLC_LEN
    ov = np.clip(np.minimum(cs + CMP_LEN, ss + SLC_LEN) - np.maximum(cs, ss), 0, None)
    ok = (ci >= 0) & (ci < n_c)
    w = np.where(ok, ov / CMP_LEN, 0.0).astype(np.float32)
    return jnp.asarray(np.clip(ci, 0, n_c - 1)), jnp.asarray(w)


def nsa_attention(q, kv, gate_logits, g_q, g_kc, g_ks, g_kw,
                  pe_k, w1_k, w2_k, pe_v, w1_v, w2_v):
    B, S = q.shape[:2]
    G, HPG, DH = NSA_GROUPS, NSA_HPG, NSA_HEAD_DIM
    scale = DH ** -0.5
    q = rms_norm(q.reshape(B, S, NSA_HEADS, DH), g_q).reshape(B, S, G, HPG, DH)
    kc, vc, ks, vs, kw, vw = [t.reshape(B, S, G, DH) for t in jnp.split(kv, 6, axis=-1)]
    k_c = rms_norm(compress_blocks(kc, pe_k, w1_k, w2_k), g_kc)
    v_c = compress_blocks(vc, pe_v, w1_v, w2_v)
    n_c = k_c.shape[1]
    n_s = S // SLC_LEN
    n_top = min(SLC_TOP, n_s)
    k_s = rms_norm(ks, g_ks).reshape(B, n_s, SLC_LEN, G, DH).transpose(0, 3, 1, 2, 4)
    v_s = vs.reshape(B, n_s, SLC_LEN, G, DH).transpose(0, 3, 1, 2, 4)
    pad = ((0, 0), (WIN, 0), (0, 0), (0, 0))
    k_w = jnp.pad(rms_norm(kw, g_kw), pad)
    v_w = jnp.pad(vw, pad)
    gates = jax.nn.sigmoid(gate_logits.reshape(B, S, G, HPG, 3))
    slc_idx, slc_w = selection_map(n_c, n_s)
    cmp_end = jnp.arange(n_c) * CMP_STRIDE + CMP_LEN - 1
    blk_ids = jnp.arange(n_s)
    b_ix = jnp.arange(B)[:, None, None, None]
    g_ix = jnp.arange(G)[None, None, :, None]

    def block(c):
        t0 = c * Q_BLOCK
        t = t0 + jnp.arange(Q_BLOCK)
        qb = lax.dynamic_slice_in_dim(q, t0, Q_BLOCK, axis=1)
        s_c = jnp.einsum('bqghd,bngd->bqghn', qb, k_c) * scale
        valid_c = cmp_end[None, :] <= t[:, None]
        p_c = masked_softmax(s_c, valid_c[None, :, None, None, :])
        o_c = jnp.einsum('bqghn,bngd->bqghd', p_c.astype(v_c.dtype), v_c)
        imp_c = jnp.sum(p_c, axis=3)
        imp_s = jnp.sum(imp_c[..., slc_idx] * slc_w, axis=-1)
        cur = t // SLC_LEN
        valid_s = blk_ids[None, :] <= cur[:, None]
        forced = ((blk_ids[None, :] == 0) | (blk_ids[None, :] == cur[:, None])
                  | (blk_ids[None, :] == cur[:, None] - 1))
        score = jnp.where(forced[None, :, None, :], FORCE_SCORE,
                          jnp.where(valid_s[None, :, None, :], imp_s, NEG_INF))
        _, sel = lax.top_k(score, n_top)
        k_sel = k_s[b_ix, g_ix, sel].reshape(B, Q_BLOCK, G, n_top * SLC_LEN, DH)
        v_sel = v_s[b_ix, g_ix, sel].reshape(B, Q_BLOCK, G, n_top * SLC_LEN, DH)
        kpos = (sel[..., None] * SLC_LEN + jnp.arange(SLC_LEN)).reshape(B, Q_BLOCK, G, n_top * SLC_LEN)
        valid_sel = kpos <= t[None, :, None, None]
        s_s = jnp.einsum('bqghd,bqgkd->bqghk', qb, k_sel) * scale
        p_s = masked_softmax(s_s, valid_sel[:, :, :, None, :])
        o_s = jnp.einsum('bqghk,bqgkd->bqghd', p_s.astype(v_sel.dtype), v_sel)
        kw_b = lax.dynamic_slice_in_dim(k_w, t0, Q_BLOCK + WIN, axis=1)
        vw_b = lax.dynamic_slice_in_dim(v_w, t0, Q_BLOCK + WIN, axis=1)
        pos = t0 - WIN + jnp.arange(Q_BLOCK + WIN)
        valid_w = (pos[None, :] >= 0) & (pos[None, :] <= t[:, None]) & (pos[None, :] > t[:, None] - WIN)
        s_w = jnp.einsum('bqghd,bkgd->bqghk', qb, kw_b) * scale
        p_w = masked_softmax(s_w, valid_w[None, :, None, None, :])
        o_w = jnp.einsum('bqghk,bkgd->bqghd', p_w.astype(vw_b.dtype), vw_b)
        gb = lax.dynamic_slice_in_dim(gates, t0, Q_BLOCK, axis=1)
        o = gb[..., 0:1] * o_c + gb[..., 1:2] * o_s + gb[..., 2:3] * o_w
        return o.reshape(B, Q_BLOCK, NSA_HEADS * DH)

    out = lax.map(block, jnp.arange(S // Q_BLOCK))
    return jnp.moveaxis(out, 0, 1).reshape(B, S, NSA_HEADS * DH)


def memory_cross_attention(q, mem_h, w_kv, g_q, g_k):
    B, S = q.shape[:2]
    M = mem_h.shape[1]
    km, vm = jnp.split(mem_h @ w_kv, 2, axis=-1)
    km = rms_norm(km.reshape(B, M, MEM_HEADS, MEM_HEAD_DIM), g_k)
    vm = vm.reshape(B, M, MEM_HEADS, MEM_HEAD_DIM)
    q = rms_norm(q.reshape(B, S, MEM_HEADS, MEM_HEAD_DIM), g_q)
    s = jnp.einsum('bshd,bmhd->bhsm', q, km).astype(jnp.float32) * MEM_HEAD_DIM ** -0.5
    p = jax.nn.softmax(s, axis=-1).astype(vm.dtype)
    return jnp.einsum('bhsm,bmhd->bshd', p, vm).reshape(B, S, BRANCH_WIDTH)


def setup_inputs(seed: int = 0) -> dict:
    key = jax.random.key(seed)
    ks = iter(jax.random.split(key, 40))

    def w(shape, fan_in):
        return jax.random.normal(next(ks), (DEPTH,) + shape, jnp.float32) * fan_in ** -0.5

    def gain(n):
        return 1.0 + 0.02 * jax.random.normal(next(ks), (DEPTH, n), jnp.float32)

    x = jax.random.normal(next(ks), (BATCH, SEQ, D_MODEL), jnp.float32)
    mem = jax.random.normal(next(ks), (BATCH, MEM_LEN, D_MODEL), jnp.float32)
    return {
        'x': x,
        'mem': mem,
        'ffn1_norm': gain(D_MODEL),
        'ffn1_w_gate': w((D_MODEL, D_FF), D_MODEL),
        'ffn1_w_up': w((D_MODEL, D_FF), D_MODEL),
        'ffn1_w_down': w((D_FF, D_MODEL), D_FF),
        'mix_norm': gain(D_MODEL),
        'mem_norm': gain(D_MODEL),
        'w_in': w((D_MODEL, D_IN), D_MODEL),
        'conv_w': w((CONV_K, CONV_WIDTH), CONV_K),
        'nsa_q_norm': gain(NSA_HEAD_DIM),
        'nsa_kc_norm': gain(NSA_HEAD_DIM),
        'nsa_ks_norm': gain(NSA_HEAD_DIM),
        'nsa_kw_norm': gain(NSA_HEAD_DIM),
        'cmp_pe_k': 0.1 * jax.random.normal(next(ks), (DEPTH, CMP_LEN, NSA_HEAD_DIM), jnp.float32),
        'cmp_w1_k': w((CMP_LEN * NSA_HEAD_DIM, CMP_HIDDEN), CMP_LEN * NSA_HEAD_DIM),
        'cmp_w2_k': w((CMP_HIDDEN, NSA_HEAD_DIM), CMP_HIDDEN),
        'cmp_pe_v': 0.1 * jax.random.normal(next(ks), (DEPTH, CMP_LEN, NSA_HEAD_DIM), jnp.float32),
        'cmp_w1_v': w((CMP_LEN * NSA_HEAD_DIM, CMP_HIDDEN), CMP_LEN * NSA_HEAD_DIM),
        'cmp_w2_v': w((CMP_HIDDEN, NSA_HEAD_DIM), CMP_HIDDEN),
        'w_mem_kv': w((D_MODEL, 2 * BRANCH_WIDTH), D_MODEL),
        'mem_q_norm': gain(MEM_HEAD_DIM),
        'mem_k_norm': gain(MEM_HEAD_DIM),
        'w_branch': w((N_BRANCH, BRANCH_WIDTH, D_MODEL), BRANCH_WIDTH),
        'w_o': w((D_MODEL, D_MODEL), D_MODEL),
        'ffn2_norm': gain(D_MODEL),
        'ffn2_w_gate': w((D_MODEL, D_FF), D_MODEL),
        'ffn2_w_up': w((D_MODEL, D_FF), D_MODEL),
        'ffn2_w_down': w((D_FF, D_MODEL), D_FF),
    }


def reference(x, mem, ffn1_norm, ffn1_w_gate, ffn1_w_up, ffn1_w_down, mix_norm, mem_norm,
              w_in, conv_w, nsa_q_norm, nsa_kc_norm, nsa_ks_norm, nsa_kw_norm,
              cmp_pe_k, cmp_w1_k, cmp_w2_k, cmp_pe_v, cmp_w1_v, cmp_w2_v,
              w_mem_kv, mem_q_norm, mem_k_norm, w_branch, w_o,
              ffn2_norm, ffn2_w_gate, ffn2_w_up, ffn2_w_down):
    B, S, D = x.shape
    split_at = np.cumsum(IN_SPLITS)[:-1].tolist()
    for l in range(DEPTH):
        h = rms_norm(x, ffn1_norm[l])
        x = x + 0.5 * swiglu(h, ffn1_w_gate[l], ffn1_w_up[l], ffn1_w_down[l])
        h = rms_norm(x, mix_norm[l])
        z = h @ w_in[l]
        b_g, c_g, u, q_nsa, kv_nsa, g_nsa, q_mem, g_merge = jnp.split(z, split_at, axis=-1)
        y_conv = short_conv_mixer(b_g, c_g, u, conv_w[l])
        y_nsa = nsa_attention(q_nsa, kv_nsa, g_nsa, nsa_q_norm[l], nsa_kc_norm[l],
                              nsa_ks_norm[l], nsa_kw_norm[l], cmp_pe_k[l], cmp_w1_k[l],
                              cmp_w2_k[l], cmp_pe_v[l], cmp_w1_v[l], cmp_w2_v[l])
        y_mem = memory_cross_attention(q_mem, rms_norm(mem, mem_norm[l]), w_mem_kv[l],
                                       mem_q_norm[l], mem_k_norm[l])
        ys = jnp.stack([y_conv, y_nsa, y_mem], axis=2)
        yb = jnp.einsum('bsnc,ncd->bsnd', ys, w_branch[l])
        gate = jax.nn.sigmoid(g_merge.reshape(B, S, N_BRANCH, D))
        merged = jnp.einsum('bsnd,bsnd->bsd', gate, yb)
        x = x + merged @ w_o[l]
        h = rms_norm(x, ffn2_norm[l])
        x = x + 0.5 * swiglu(h, ffn2_w_gate[l], ffn2_w_up[l], ffn2_w_down[l])
    return x
```

```cpp
#include <hip/hip_runtime.h>
#include <hip/hip_cooperative_groups.h>
#include <cstdio>
#include <cstdint>
namespace cg = cooperative_groups;

namespace pg8 {
#define PG8_LAS __attribute__((address_space(3)))
typedef unsigned short bf16_t;
typedef short bf16x8 __attribute__((ext_vector_type(8)));
typedef float f32x4 __attribute__((ext_vector_type(4)));
typedef unsigned u32x4 __attribute__((ext_vector_type(4)));
constexpr int BM = 256, BK = 64, HALF = 128, HTB = HALF * BK * 2, STAGE_BYTES = 8 * HTB, NXCD = 8, WGM = 8;
__host__ __device__ __forceinline__ int lds_byte(int r, int c) { const int st = (r >> 4) * 2 + (c >> 5), rr = r & 15, cc = c & 31, ob = rr * 64 + cc * 2; return st * 1024 + (ob ^ (((ob >> 9) & 1) << 5)); }
__host__ __device__ __forceinline__ void stage_rc(int b, int& R, int& C) { const int st = b / 1024, sb = b % 1024, swz = sb ^ (((sb >> 9) & 1) << 5); R = (st >> 1) * 16 + swz / 64; C = (st & 1) * 32 + (swz % 64) / 2; }
__host__ __device__ __forceinline__ int perm32(int rho) { const int n = rho >> 4, i = rho & 15; return 8 * (i >> 2) + 4 * n + (i & 3); }

struct Unit { int pm, pn; int aoff; };
struct Gemm { const bf16_t* A; const bf16_t* Bt; int M, N, K; int lda; int cmp; int ldb; };

struct Order {
    int nM, nN, nwg, G, c, mode; int a1off, a2off, ksa, ksb;
    __device__ void init(int M, int N, int G_, int c_, int mode_) { nM = M / BM; nN = N / BM; nwg = nM * nN; G = G_; c = c_; mode = mode_; a1off = 0; a2off = 0; ksa = 0; ksb = 0; }
    __device__ bool next(int i, Unit& u) const {
        if (mode == 1) { const int tile = c + (i / 3) * G; if (tile >= nM * 8) return false; const int n = i % 3; int pm_ = tile >> 3, po_ = tile & 7;
            if (G == 256 && nM == 32) { const int x_ = c & 7, q_ = c >> 3; pm_ = 4 * x_ + (q_ >> 3); po_ = q_ & 7; }
            u.pm = pm_; u.pn = n * 8 + po_; u.aoff = n * 2048; return true; }
        if (mode == 2) { const long L = (long)i * G + c; if (L >= nM * 2) return false; u.pm = (int)(L >> 1); u.pn = (int)(L & 1); u.aoff = (L & 1) ? a2off : a1off; return true; }
        const long L = (long)i * G + c; if (L >= nwg) return false;
        int wgid = (int)L; { const int q = nwg / NXCD, r = nwg % NXCD, xcd = wgid % NXCD, off = wgid / NXCD; wgid = (xcd < r ? xcd * (q + 1) : r * (q + 1) + (xcd - r) * q) + off; }
        const int nig = WGM * nN, gid = wgid / nig, fm = gid * WGM, gsz = (nM - fm) < WGM ? (nM - fm) : WGM;
        u.pm = fm + ((wgid % nig) % gsz); u.pn = (wgid % nig) / gsz; u.aoff = 0; return true;
    }
    __device__ __forceinline__ void a_ready(const Unit&) const {}
    __device__ __forceinline__ void done(const Unit&) const {}
};
__device__ __forceinline__ unsigned cvt_pk_bf16(float lo, float hi) { unsigned r; asm volatile("v_cvt_pk_bf16_f32 %0, %1, %2" : "=v"(r) : "v"(lo), "v"(hi)); return r; }
__device__ __forceinline__ float sigm(float x) { return __builtin_amdgcn_rcpf(1.0f + __builtin_amdgcn_exp2f(-1.4426950408889634f * x)); }
__device__ __forceinline__ float bflo(unsigned w) { return __uint_as_float(w << 16); }
__device__ __forceinline__ float bfhi(unsigned w) { return __uint_as_float(w & 0xffff0000u); }


struct EpiSwiGLU {
    static constexpr bool PERM = true, AFTER_DRAIN = false; bf16_t* O; int ldc;
    __device__ __forceinline__ void operator()(const f32x4 (&acc)[2][2][4][2], const Unit& u, int wr, int wc, int fr, int fq) const {
        const int row0 = u.pm * BM + wr * 64 + fr, col0 = u.pn * HALF + wc * 32 + 8 * fq;
#pragma unroll
        for (int ai = 0; ai < 2; ++ai)
#pragma unroll
            for (int m = 0; m < 4; ++m) { bf16_t* rowp = O + (size_t)(row0 + ai * HALF + m * 16) * ldc + col0;
                f32x4 v[2];
#pragma unroll
                for (int n = 0; n < 2; ++n) { const f32x4 gt = acc[ai][0][m][n], up = acc[ai][1][m][n];
#pragma unroll
                    for (int e = 0; e < 4; ++e) v[n][e] = gt[e] * sigm(gt[e]) * up[e]; }
                u32x4 w; w.x = cvt_pk_bf16(v[0][0], v[0][1]); w.y = cvt_pk_bf16(v[0][2], v[0][3]); w.z = cvt_pk_bf16(v[1][0], v[1][1]); w.w = cvt_pk_bf16(v[1][2], v[1][3]);
                *(u32x4*)rowp = w; }
    }
};
struct EpiResid {
    static constexpr bool PERM = false, AFTER_DRAIN = false; const float* base; float* out; int ldc; float scale;
    __device__ __forceinline__ void operator()(const f32x4 (&acc)[2][2][4][2], const Unit& u, int wr, int wc, int fr, int fq) const {
        const int col0 = u.pn * BM + wc * 32 + 4 * fq;
        const size_t off0 = (size_t)(u.pm * BM + wr * 64 + fr) * ldc + col0;
        f32x4 cur[2][2], nxt[2][2];
#pragma unroll
        for (int bj = 0; bj < 2; ++bj)
#pragma unroll
            for (int n = 0; n < 2; ++n) cur[bj][n] = *(const f32x4*)(base + off0 + bj * HALF + n * 16);
#pragma unroll
        for (int gi = 0; gi < 8; ++gi) { const int ai = gi >> 2, m = gi & 3; const size_t off = off0 + (size_t)(ai * HALF + m * 16) * ldc;
            if (gi + 1 < 8) { const size_t offn = off0 + (size_t)(((gi + 1) >> 2) * HALF + ((gi + 1) & 3) * 16) * ldc;
#pragma unroll
                for (int bj = 0; bj < 2; ++bj)
#pragma unroll
                    for (int n = 0; n < 2; ++n) nxt[bj][n] = *(const f32x4*)(base + offn + bj * HALF + n * 16); }
#pragma unroll
            for (int bj = 0; bj < 2; ++bj)
#pragma unroll
                for (int n = 0; n < 2; ++n) { *(f32x4*)(out + off + bj * HALF + n * 16) = cur[bj][n] + acc[ai][bj][m][n] * scale; cur[bj][n] = nxt[bj][n]; }
            asm volatile("" ::: "memory"); }
    }
};
struct EpiStore {
    static constexpr bool PERM = true, AFTER_DRAIN = false; bf16_t* O0; int ld0; int npn0; bf16_t* O1; int ld1;
    __device__ __forceinline__ void operator()(const f32x4 (&acc)[2][2][4][2], const Unit& u, int wr, int wc, int fr, int fq) const {
        const bool sg = u.pn >= npn0; bf16_t* O = sg ? O1 : O0; const int ldc = sg ? ld1 : ld0; const int colt = (sg ? u.pn - npn0 : u.pn) * BM + wc * 32 + 8 * fq;
        const int row0 = u.pm * BM + wr * 64 + fr;
#pragma unroll
        for (int ai = 0; ai < 2; ++ai)
#pragma unroll
            for (int m = 0; m < 4; ++m) { bf16_t* rowp = O + (size_t)(row0 + ai * HALF + m * 16) * ldc + colt;
#pragma unroll
                for (int bj = 0; bj < 2; ++bj) { f32x4 v0 = acc[ai][bj][m][0], v1 = acc[ai][bj][m][1];
                    if (sg) {
#pragma unroll
                        for (int e = 0; e < 4; ++e) { v0[e] = sigm(v0[e]); v1[e] = sigm(v1[e]); } }
                    u32x4 w; w.x = cvt_pk_bf16(v0[0], v0[1]); w.y = cvt_pk_bf16(v0[2], v0[3]); w.z = cvt_pk_bf16(v1[0], v1[1]); w.w = cvt_pk_bf16(v1[2], v1[3]);
                    *(u32x4*)(rowp + bj * HALF) = w; } }
    }
};
struct EpiCmp {
    static constexpr bool PERM = true, AFTER_DRAIN = false; bf16_t* hid; const float* bias; int nvalid;
    __device__ __forceinline__ void operator()(const f32x4 (&acc)[2][2][4][2], const Unit& u, int wr, int wc, int fr, int fq) const {
        bf16_t* O = hid + (size_t)u.pn * 2048 * 256; const float* bb = bias + u.pn * 256;
        const int row0 = u.pm * BM + wr * 64 + fr, col0 = wc * 32 + 8 * fq;
#pragma unroll
        for (int ai = 0; ai < 2; ++ai)
#pragma unroll
            for (int m = 0; m < 4; ++m) { const int row = row0 + ai * HALF + m * 16;
#pragma unroll
                for (int bj = 0; bj < 2; ++bj) { const f32x4 b0 = *(const f32x4*)(bb + col0 + bj * HALF), b1 = *(const f32x4*)(bb + col0 + bj * HALF + 4);
                    f32x4 v0 = acc[ai][bj][m][0] + b0, v1 = acc[ai][bj][m][1] + b1;
#pragma unroll
                    for (int e = 0; e < 4; ++e) { v0[e] = v0[e] * sigm(v0[e]); v1[e] = v1[e] * sigm(v1[e]); }
                    u32x4 w; w.x = cvt_pk_bf16(v0[0], v0[1]); w.y = cvt_pk_bf16(v0[2], v0[3]); w.z = cvt_pk_bf16(v1[0], v1[1]); w.w = cvt_pk_bf16(v1[2], v1[3]);
                    if (row < nvalid) *(u32x4*)(O + (size_t)row * 256 + col0 + bj * HALF) = w; } }
    }
};
struct EpiMerge {
    static constexpr bool PERM = true, AFTER_DRAIN = false; const bf16_t* gate; int ldg; float* mf; bf16_t* merged;
    __device__ __forceinline__ void operator()(const f32x4 (&acc)[2][2][4][2], const Unit& u, int wr, int wc, int fr, int fq) const {
        const int nbr = u.pn >> 3, pno = u.pn & 7;
        const int row0 = u.pm * BM + wr * 64 + fr, gcol = u.pn * BM + wc * 32 + 8 * fq, ocol = pno * BM + wc * 32 + 8 * fq;
        u32x4 gcur[2], gnxt[2]; f32x4 mcur[2][2], mnxt[2][2];
#pragma unroll
        for (int bj = 0; bj < 2; ++bj) { gcur[bj] = *(const u32x4*)(gate + (size_t)row0 * ldg + gcol + bj * HALF);
            if (nbr > 0) { const float* mp = mf + (size_t)row0 * 2048 + ocol + bj * HALF; mcur[bj][0] = *(const f32x4*)mp; mcur[bj][1] = *(const f32x4*)(mp + 4); } }
#pragma unroll
        for (int gi = 0; gi < 8; ++gi) { const int ai = gi >> 2, m = gi & 3; const int row = row0 + ai * HALF + m * 16;
            if (gi + 1 < 8) { const int rown = row0 + ((gi + 1) >> 2) * HALF + ((gi + 1) & 3) * 16;
#pragma unroll
                for (int bj = 0; bj < 2; ++bj) { gnxt[bj] = *(const u32x4*)(gate + (size_t)rown * ldg + gcol + bj * HALF);
                    if (nbr > 0) { const float* mp = mf + (size_t)rown * 2048 + ocol + bj * HALF; mnxt[bj][0] = *(const f32x4*)mp; mnxt[bj][1] = *(const f32x4*)(mp + 4); } } }
#pragma unroll
            for (int bj = 0; bj < 2; ++bj) { const u32x4 gw = gcur[bj];
                f32x4 v0 = acc[ai][bj][m][0], v1 = acc[ai][bj][m][1];
                v0[0] *= bflo(gw.x); v0[1] *= bfhi(gw.x); v0[2] *= bflo(gw.y); v0[3] *= bfhi(gw.y); v1[0] *= bflo(gw.z); v1[1] *= bfhi(gw.z); v1[2] *= bflo(gw.w); v1[3] *= bfhi(gw.w);
                float* mp = mf + (size_t)row * 2048 + ocol + bj * HALF;
                if (nbr > 0) { v0 += mcur[bj][0]; v1 += mcur[bj][1]; }
                if (nbr < 2) { *(f32x4*)mp = v0; *(f32x4*)(mp + 4) = v1; }
                else { u32x4 w; w.x = cvt_pk_bf16(v0[0], v0[1]); w.y = cvt_pk_bf16(v0[2], v0[3]); w.z = cvt_pk_bf16(v1[0], v1[1]); w.w = cvt_pk_bf16(v1[2], v1[3]);
                    *(u32x4*)(merged + (size_t)row * 2048 + ocol + bj * HALF) = w; }
                gcur[bj] = gnxt[bj]; mcur[bj][0] = mnxt[bj][0]; mcur[bj][1] = mnxt[bj][1]; }
            asm volatile("" ::: "memory"); }
    }
};

template <class Epi, class Sched, bool ALIGN_EPI = false, bool SP2 = false>
__device__ __forceinline__ void gemm_phase(PG8_LAS unsigned char* lds, const Gemm g, const Sched& S, const Epi& E, int wave_id) {
    unsigned lm_ = ~0u; asm volatile("" : "+s"(lm_)); int tid_ = (wave_id << 6) | (int)__builtin_amdgcn_mbcnt_hi(lm_, __builtin_amdgcn_mbcnt_lo(lm_, 0u));     const int tid = tid_, wid = __builtin_amdgcn_readfirstlane(tid >> 6), lane = tid & 63, wr = wid >> 2, wc = wid & 3, fr = lane & 15, fq = lane >> 4;
    const int K = g.K, nt = K / BK;
    unsigned voffA[2], voffB[2];
#pragma unroll
    for (int i = 0; i < 2; ++i) { int R, C; stage_rc(tid * 16 + i * 8192, R, C); const int Rb = Epi::PERM ? ((R & ~31) + perm32(R & 31)) : R;
        voffA[i] = g.cmp ? (unsigned)(((R >> 2) * 16 * g.lda + (R & 3) * 64 + C) * 2) : (unsigned)(R * g.lda + C) * 2u; voffB[i] = (unsigned)(Rb * g.ldb + C) * 2u; }
    const size_t kstep = (size_t)(BK * 2);
    const size_t hstep = (size_t)HALF * g.ldb * 2;
    const size_t tstep = 2 * hstep; const size_t kstepA = g.cmp ? (size_t)g.lda * 2 : (size_t)(BK * 2); const size_t hstepA = g.cmp ? (size_t)32 * 16 * g.lda * 2 : (size_t)HALF * g.lda * 2; const size_t tstepA = 2 * hstepA;
    const unsigned ldsw = (unsigned)wid * 1024u;
    const int aoff = lds_byte(wr * 64 + fr, fq * 8), boff = lds_byte(wc * 32 + fr, fq * 8);
#define PG8_SA(b, h) (((b) * 2 + (h)) * HTB)
#define PG8_SB(b, h) ((4 + (b) * 2 + (h)) * HTB)
#define PG8_STAGE(bufoff, gbase, voff) do { _Pragma("unroll") for (int _i = 0; _i < 2; ++_i) \
        __builtin_amdgcn_global_load_lds((const unsigned*)((const char*)(gbase) + (voff)[_i]), (PG8_LAS unsigned*)(lds + (bufoff) + ldsw + _i * 8192), 16, 0, 0); } while (0)
#define PG8_LDA(dst, b, h) do { _Pragma("unroll") for (int m = 0; m < 4; ++m) _Pragma("unroll") for (int k = 0; k < 2; ++k) dst[m][k] = *(const PG8_LAS bf16x8*)(lds + PG8_SA(b, h) + aoff + m * 2048 + k * 1024); } while (0)
#define PG8_LDB(dst, b, h) do { _Pragma("unroll") for (int n = 0; n < 2; ++n) _Pragma("unroll") for (int k = 0; k < 2; ++k) dst[n][k] = *(const PG8_LAS bf16x8*)(lds + PG8_SB(b, h) + boff + n * 2048 + k * 1024); } while (0)
#define PG8_MMA(ai, bj, At, Bt) do { __builtin_amdgcn_s_setprio(1); _Pragma("unroll") for (int m = 0; m < 4; ++m) _Pragma("unroll") for (int n = 0; n < 2; ++n) _Pragma("unroll") for (int k = 0; k < 2; ++k) \
        acc[ai][bj][m][n] = __builtin_amdgcn_mfma_f32_16x16x32_bf16(Bt[n][k], At[m][k], acc[ai][bj][m][n], 0, 0, 0); __builtin_amdgcn_s_setprio(0); } while (0)
#define PG8_WAIT_V(n) asm volatile("s_waitcnt vmcnt(" #n ")" ::: "memory")
#define PG8_WAIT_L(n) asm volatile("s_waitcnt lgkmcnt(" #n ")" ::: "memory")
#define PG8_BAR __builtin_amdgcn_s_barrier()
#define PG8_SCHED __builtin_amdgcn_sched_barrier(0)
    Unit cur, nxt; int ui = 0;
    if (!S.next(0, cur)) return;
    f32x4 acc[2][2][4][2];
    { f32x4 zq_ = {0.f, 0.f, 0.f, 0.f}; asm volatile("" : "+v"(zq_));
#pragma unroll
    for (int a = 0; a < 2; ++a)
#pragma unroll
        for (int b = 0; b < 2; ++b)
#pragma unroll
            for (int m = 0; m < 4; ++m)
#pragma unroll
                for (int n = 0; n < 2; ++n) acc[a][b][m][n] = zq_; }
    bf16x8 At[4][2], B0[2][2], B1[2][2];
    const char* cA = (const char*)g.A + (size_t)cur.pm * tstepA + cur.aoff; const char* cB = (const char*)g.Bt + (size_t)(cur.pn & 255) * tstep + (size_t)(cur.pn >> 8) * 512;
    S.a_ready(cur);
    if constexpr (SP2) {
        PG8_STAGE(PG8_SB(0, 0), cB, voffB); PG8_STAGE(PG8_SB(0, 1), cB + hstep, voffB); PG8_STAGE(PG8_SA(0, 0), cA, voffA); PG8_STAGE(PG8_SA(0, 1), cA + hstepA, voffA);
        if (wr == 1) PG8_BAR;
        PG8_WAIT_V(2); PG8_BAR;
        PG8_STAGE(PG8_SB(1, 0), cB + kstep, voffB); PG8_STAGE(PG8_SA(1, 0), cA + kstepA, voffA); PG8_STAGE(PG8_SB(1, 1), cB + hstep + kstep, voffB);
        PG8_WAIT_V(6); PG8_BAR;
    } else {
        PG8_STAGE(PG8_SB(0, 0), cB, voffB); PG8_STAGE(PG8_SA(0, 0), cA, voffA); PG8_STAGE(PG8_SB(0, 1), cB + hstep, voffB); PG8_STAGE(PG8_SA(0, 1), cA + hstepA, voffA);
        if (wr == 1) PG8_BAR;
        PG8_WAIT_V(4); PG8_BAR;
        PG8_STAGE(PG8_SB(1, 0), cB + kstep, voffB); PG8_STAGE(PG8_SA(1, 0), cA + kstepA, voffA); PG8_STAGE(PG8_SB(1, 1), cB + hstep + kstep, voffB);
        PG8_WAIT_V(6); PG8_BAR;
    }
    for (;;) {
        const bool has_next = S.next(ui + 1, nxt);
        const char* nA = has_next ? (const char*)g.A + (size_t)nxt.pm * tstepA + nxt.aoff : cA; const char* nB = has_next ? (const char*)g.Bt + (size_t)(nxt.pn & 255) * tstep + (size_t)(nxt.pn >> 8) * 512 : cB;
        for (int t = 0; t < nt; t += 2) {
            const bool last = (t == nt - 2);
            const char* a1 = cA + (size_t)(t + 1) * kstepA;
            const char* a2 = last ? nA : cA + (size_t)(t + 2) * kstepA; const char* b2 = last ? nB : cB + (size_t)(t + 2) * kstep;
            const char* a3 = a2 + kstepA; const char* b3 = b2 + kstep;
            if (last && has_next) S.a_ready(nxt);
            if constexpr (SP2) {
            PG8_LDB(B0, 0, 0); PG8_LDB(B1, 0, 1); PG8_SCHED; PG8_LDA(At, 0, 0); PG8_STAGE(PG8_SA(1, 1), a1 + hstepA, voffA);
            PG8_WAIT_V(8); PG8_WAIT_L(0); PG8_BAR; PG8_MMA(0, 0, At, B0); PG8_MMA(0, 1, At, B1); PG8_BAR; PG8_SCHED;
            PG8_LDA(At, 0, 1); PG8_STAGE(PG8_SB(0, 0), b2, voffB); PG8_STAGE(PG8_SB(0, 1), b2 + hstep, voffB); PG8_STAGE(PG8_SA(0, 0), a2, voffA);
            PG8_WAIT_V(8); PG8_WAIT_L(0); PG8_BAR; PG8_MMA(1, 0, At, B0); PG8_MMA(1, 1, At, B1); PG8_BAR; PG8_SCHED;
            PG8_LDB(B0, 1, 0); PG8_LDB(B1, 1, 1); PG8_SCHED; PG8_LDA(At, 1, 0); PG8_STAGE(PG8_SA(0, 1), a2 + hstepA, voffA);
            PG8_WAIT_V(8); PG8_WAIT_L(0); PG8_BAR; PG8_MMA(0, 0, At, B0); PG8_MMA(0, 1, At, B1); PG8_BAR; PG8_SCHED;
            PG8_LDA(At, 1, 1); PG8_STAGE(PG8_SB(1, 0), b3, voffB); PG8_STAGE(PG8_SB(1, 1), b3 + hstep, voffB); PG8_STAGE(PG8_SA(1, 0), a3, voffA);
            PG8_WAIT_V(8); PG8_WAIT_L(0); PG8_BAR; PG8_MMA(1, 0, At, B0); PG8_MMA(1, 1, At, B1); PG8_BAR; PG8_SCHED;
            } else {
            PG8_LDB(B0, 0, 0); PG8_SCHED; PG8_LDA(At, 0, 0); PG8_STAGE(PG8_SA(1, 1), a1 + hstepA, voffA);
            PG8_WAIT_L(8); PG8_BAR; PG8_WAIT_L(0); PG8_MMA(0, 0, At, B0); PG8_BAR; PG8_SCHED;
            PG8_LDB(B1, 0, 1); PG8_STAGE(PG8_SB(0, 0), b2, voffB);
            PG8_BAR; PG8_WAIT_L(0); PG8_MMA(0, 1, At, B1); PG8_BAR;
            PG8_LDA(At, 0, 1); PG8_STAGE(PG8_SA(0, 0), a2, voffA);
            PG8_BAR; PG8_WAIT_L(0); PG8_MMA(1, 0, At, B0); PG8_BAR; PG8_SCHED;
            PG8_STAGE(PG8_SB(0, 1), b2 + hstep, voffB);
            PG8_WAIT_V(6); PG8_BAR; PG8_MMA(1, 1, At, B1); PG8_BAR;
            PG8_LDB(B0, 1, 0); PG8_SCHED; PG8_LDA(At, 1, 0); PG8_STAGE(PG8_SA(0, 1), a2 + hstepA, voffA);
            PG8_WAIT_L(8); PG8_BAR; PG8_WAIT_L(0); PG8_MMA(0, 0, At, B0); PG8_BAR; PG8_SCHED;
            PG8_LDB(B1, 1, 1); PG8_STAGE(PG8_SB(1, 0), b3, voffB);
            PG8_BAR; PG8_WAIT_L(0); PG8_MMA(0, 1, At, B1); PG8_BAR;
            PG8_LDA(At, 1, 1); PG8_STAGE(PG8_SA(1, 0), a3, voffA);
            PG8_BAR; PG8_WAIT_L(0); PG8_MMA(1, 0, At, B0); PG8_BAR; PG8_SCHED;
            PG8_STAGE(PG8_SB(1, 1), b3 + hstep, voffB);
            PG8_WAIT_V(6); PG8_BAR; PG8_MMA(1, 1, At, B1); PG8_BAR;
            }
        }
        if constexpr (ALIGN_EPI) { if (wr == 0) PG8_BAR; }
        if constexpr (!Epi::AFTER_DRAIN) { E(acc, cur, wr, wc, fr, fq); S.done(cur); }
        if (!has_next) break;
        { f32x4 zq_ = {0.f, 0.f, 0.f, 0.f}; asm volatile("" : "+v"(zq_));
#pragma unroll
        for (int a = 0; a < 2; ++a)
#pragma unroll
            for (int b = 0; b < 2; ++b)
#pragma unroll
                for (int m = 0; m < 4; ++m)
#pragma unroll
                    for (int n = 0; n < 2; ++n) acc[a][b][m][n] = zq_; }
        cur = nxt; cA = nA; cB = nB; ++ui;
        if constexpr (ALIGN_EPI) { if (wr == 1) PG8_BAR; }
    }
    PG8_WAIT_V(0);
    if constexpr (!ALIGN_EPI) { if (wr == 0) PG8_BAR; }
    PG8_BAR;
    if constexpr (Epi::AFTER_DRAIN) { E.fused(acc, cur, wr, wc, fr, fq, lds, wid, lane); S.done(cur); }
#undef PG8_SA
#undef PG8_SB
#undef PG8_STAGE
#undef PG8_LDA
#undef PG8_LDB
#undef PG8_MMA
#undef PG8_WAIT_V
#undef PG8_WAIT_L
#undef PG8_BAR
#undef PG8_SCHED
}
}

#define LAS __attribute__((address_space(3)))
typedef unsigned short bf16_t;
typedef short bf16x8 __attribute__((ext_vector_type(8)));
typedef float f32x4 __attribute__((ext_vector_type(4)));
typedef unsigned u32x4 __attribute__((ext_vector_type(4)));
typedef unsigned u32x2 __attribute__((ext_vector_type(2)));
using pg8::cvt_pk_bf16; using pg8::sigm; using pg8::bflo; using pg8::bfhi;

constexpr int DM = 2048, SEQ = 8192, MTOK = 16384, DFF = 5632;
constexpr int ZM = 6912, ZG = 6144, NZ0 = 27;
constexpr int ZC_B = 0, ZC_Q = 1024, ZC_QM = 2048, ZC_C = 3072, ZC_U = 4096, ZC_KC = 5120, ZC_VC = 5376, ZC_KS = 5632, ZC_VS = 5888, ZC_KW = 6144, ZC_VW = 6400, ZC_G = 6656;
constexpr float EPS = 1e-6f, LOG2E = 1.4426950408889634f;
constexpr size_t MiB = 1u << 20;
constexpr size_t WS_WIN = 1 * MiB, WS_WMK = 52 * MiB, WS_WBR = 60 * MiB, WS_WO = 72 * MiB, WS_WC1 = 80 * MiB, WS_BIASC = 82 * MiB, WS_MEMN = 83 * MiB, WS_KVM = 85 * MiB, WS_VMT = 87 * MiB;
constexpr size_t WS_WGU2 = 88 * MiB, WS_WD2 = 132 * MiB, WS_H = 154 * MiB, WS_MF = 218 * MiB, WS_WGU1 = 282 * MiB, WS_WD1 = 326 * MiB, WS_ACT = 348 * MiB, WS_END = 524 * MiB;
constexpr size_t WS_ZMAIN = 282 * MiB, WS_ZGATE = 390 * MiB, WS_VST = 486 * MiB, WS_VWT = 490 * MiB, WS_HID = 494 * MiB, WS_KC = 496 * MiB, WS_VCT = 497 * MiB;
constexpr int LDS_BYTES = 147456;
constexpr int NPHASE = 19;

#define LDS_WAIT() asm volatile("s_waitcnt lgkmcnt(0)" ::: "memory")
__device__ __forceinline__ float bf2f(bf16_t v) { return __uint_as_float((unsigned)v << 16); }
__device__ __forceinline__ void unpack8(const u32x4 w, float (&f)[8]) { f[0] = bflo(w.x); f[1] = bfhi(w.x); f[2] = bflo(w.y); f[3] = bfhi(w.y); f[4] = bflo(w.z); f[5] = bfhi(w.z); f[6] = bflo(w.w); f[7] = bfhi(w.w); }
__device__ __forceinline__ u32x4 pack8(const float (&f)[8]) { u32x4 w; w.x = cvt_pk_bf16(f[0], f[1]); w.y = cvt_pk_bf16(f[2], f[3]); w.z = cvt_pk_bf16(f[4], f[5]); w.w = cvt_pk_bf16(f[6], f[7]); return w; }
__device__ __forceinline__ f32x4 mfma16(bf16x8 a, bf16x8 b, f32x4 c) { return __builtin_amdgcn_mfma_f32_16x16x32_bf16(a, b, c, 0, 0, 0); }
__device__ __forceinline__ float x16max(float x) { auto r = __builtin_amdgcn_permlane16_swap(__float_as_uint(x), __float_as_uint(x), false, false); return fmaxf(__uint_as_float(r[0]), __uint_as_float(r[1])); }
__device__ __forceinline__ float x32max(float x) { auto r = __builtin_amdgcn_permlane32_swap(__float_as_uint(x), __float_as_uint(x), false, false); return fmaxf(__uint_as_float(r[0]), __uint_as_float(r[1])); }
__device__ __forceinline__ float x16sum(float x) { auto r = __builtin_amdgcn_permlane16_swap(__float_as_uint(x), __float_as_uint(x), false, false); return __uint_as_float(r[0]) + __uint_as_float(r[1]); }
__device__ __forceinline__ float x32sum(float x) { auto r = __builtin_amdgcn_permlane32_swap(__float_as_uint(x), __float_as_uint(x), false, false); return __uint_as_float(r[0]) + __uint_as_float(r[1]); }
__device__ __forceinline__ float quadsum(float x) {
    x += __int_as_float(__builtin_amdgcn_update_dpp(0, __float_as_int(x), 0xB1, 0xF, 0xF, true));
    x += __int_as_float(__builtin_amdgcn_update_dpp(0, __float_as_int(x), 0x4E, 0xF, 0xF, true));
    return x; }

#define DPPF(x, ctrl) __int_as_float(__builtin_amdgcn_update_dpp(0, __float_as_int(x), (ctrl), 0xF, 0xF, true))
__device__ __forceinline__ float sum8(float x) { x += DPPF(x, 0xB1); x += DPPF(x, 0x4E); x += DPPF(x, 0x141); return x; }
__device__ __forceinline__ float sum16(float x) { x = sum8(x); x += DPPF(x, 0x140); return x; }
__device__ __forceinline__ float sum32(float x) { return x16sum(sum16(x)); }
__device__ __forceinline__ float wave_sum(float x) { return x32sum(x16sum(sum16(x))); }

__device__ __forceinline__ void tr_item(const float* W, int ldw, int col0, int ncols, int K, bf16_t* WT, int row0, int mode, LAS float* scr, int item, int lane) {
    const int nblk = (ncols + 31) >> 5, kb = item / nblk, nb = item - kb * nblk, k0 = 64 * kb, n0 = 32 * nb;
    const int nn = n0 + 4 * (lane & 7); const bool ok = nn < ncols;
    const f32x4 z4f = {0.f, 0.f, 0.f, 0.f};
#pragma unroll
    for (int i = 0; i < 8; ++i) { const int kk = 8 * i + (lane >> 3); const f32x4 v = ok ? *(const f32x4*)(W + (size_t)(k0 + kk) * ldw + col0 + nn) : z4f;
        LAS float* d = scr + kk * 33 + 4 * (lane & 7); d[0] = v.x; d[1] = v.y; d[2] = v.z; d[3] = v.w; }
    LDS_WAIT();
    const int cc = lane & 7;
#pragma unroll
    for (int j = 0; j < 4; ++j) { const int nl = (lane >> 3) + 8 * j, n = n0 + nl; const LAS float* s = scr + (8 * cc) * 33 + nl;
        u32x4 o; o.x = cvt_pk_bf16(s[0 * 33], s[1 * 33]); o.y = cvt_pk_bf16(s[2 * 33], s[3 * 33]); o.z = cvt_pk_bf16(s[4 * 33], s[5 * 33]); o.w = cvt_pk_bf16(s[6 * 33], s[7 * 33]);
        if (n < ncols) { const int drow = mode ? row0 + (n >> 7) * 256 + (n & 127) : row0 + n; *(u32x4*)(WT + (size_t)drow * K + k0 + 8 * cc) = o; } }
    LDS_WAIT();
}
__device__ __forceinline__ void rms_row(const float* xr, const float* gain, bf16_t* o, int lane) {
    const f32x4* x4 = (const f32x4*)xr + lane; const f32x4* g4 = (const f32x4*)gain + lane;
    f32x4 v[8]; float s = 0.f;
#pragma unroll
    for (int j = 0; j < 8; ++j) { v[j] = x4[64 * j]; s += (v[j].x * v[j].x + v[j].y * v[j].y) + (v[j].z * v[j].z + v[j].w * v[j].w); }
    const float r = 1.0f / sqrtf(wave_sum(s) * (1.0f / 2048.0f) + EPS);
    u32x2* o2 = (u32x2*)o + lane;
#pragma unroll
    for (int j = 0; j < 8; ++j) { const f32x4 gg = g4[64 * j]; u32x2 w; w.x = cvt_pk_bf16(v[j].x * r * gg.x, v[j].y * r * gg.y); w.y = cvt_pk_bf16(v[j].z * r * gg.z, v[j].w * r * gg.w); o2[64 * j] = w; }
}

__device__ __forceinline__ void tok_prep(bf16_t* zb, int t, const float* conv_w, const float* gq, const float* gks, const float* gkw, const float* gmq, int lane, bool do_store = true) {
    bf16_t* zr = zb + (size_t)t * ZM;
    const u32x4 z4 = {0u, 0u, 0u, 0u};
#pragma unroll
    for (int it = 0; it < 2; ++it) {
        const int col = it * 512 + lane * 8;
        const u32x4 bb = *(const u32x4*)(zr + ZC_B + col), c0 = *(const u32x4*)(zr + ZC_C + col), u0 = *(const u32x4*)(zr + ZC_U + col);
        u32x4 c1 = z4, u1 = z4, c2 = z4, u2 = z4;
        if (t >= 1) { c1 = *(const u32x4*)(zr - ZM + ZC_C + col); u1 = *(const u32x4*)(zr - ZM + ZC_U + col); }
        if (t >= 2) { c2 = *(const u32x4*)(zr - 2 * ZM + ZC_C + col); u2 = *(const u32x4*)(zr - 2 * ZM + ZC_U + col); }
        float fb[8], fc0[8], fu0[8], fc1[8], fu1[8], fc2[8], fu2[8], y[8];
        unpack8(bb, fb); unpack8(c0, fc0); unpack8(u0, fu0); unpack8(c1, fc1); unpack8(u1, fu1); unpack8(c2, fc2); unpack8(u2, fu2);
#pragma unroll
        for (int e = 0; e < 8; ++e) { const float w0 = conv_w[col + e], w1 = conv_w[1024 + col + e], w2 = conv_w[2048 + col + e];
            y[e] = fb[e] * (w0 * (fc2[e] * fu2[e]) + w1 * (fc1[e] * fu1[e]) + w2 * (fc0[e] * fu0[e])); }
        if (do_store || y[0] == 12345.678f) *(u32x4*)(zr + ZC_B + col) = pack8(y);
    }
#pragma unroll
    for (int it = 0; it < 2; ++it) {
        const int col = it * 512 + lane * 8; float q[8], y[8]; unpack8(*(const u32x4*)(zr + ZC_Q + col), q);
        float ss = 0.f;
#pragma unroll
        for (int e = 0; e < 8; ++e) ss += q[e] * q[e];
        ss = sum8(ss);
        const float r = (1.0f / sqrtf(ss * (1.0f / 64.0f) + EPS)) * (0.125f * LOG2E); const int d = col & 63;
#pragma unroll
        for (int e = 0; e < 8; ++e) y[e] = q[e] * r * gq[d + e];
        if (do_store || y[0] == 12345.678f) *(u32x4*)(zr + ZC_Q + col) = pack8(y);
    }
    {
        const int col = (lane < 32 ? ZC_KS : ZC_KW) + (lane & 31) * 8; const float* gk = lane < 32 ? gks : gkw;
        float q[8], y[8]; unpack8(*(const u32x4*)(zr + col), q);
        float ss = 0.f;
#pragma unroll
        for (int e = 0; e < 8; ++e) ss += q[e] * q[e];
        ss = sum8(ss);
        const float r = 1.0f / sqrtf(ss * (1.0f / 64.0f) + EPS); const int d = (lane * 8) & 63;
#pragma unroll
        for (int e = 0; e < 8; ++e) y[e] = q[e] * r * gk[d + e];
        if (do_store || y[0] == 12345.678f) *(u32x4*)(zr + col) = pack8(y);
    }
#pragma unroll
    for (int it = 0; it < 2; ++it) {
        const int col = it * 512 + lane * 8; float q[8], y[8]; unpack8(*(const u32x4*)(zr + ZC_QM + col), q);
        float ss = 0.f;
#pragma unroll
        for (int e = 0; e < 8; ++e) ss += q[e] * q[e];
        ss = sum32(ss);
        const float r = (1.0f / sqrtf(ss * (1.0f / 256.0f) + EPS)) * (0.0625f * LOG2E); const int d = col & 255;
#pragma unroll
        for (int e = 0; e < 8; ++e) y[e] = q[e] * r * gmq[d + e];
        if (do_store || y[0] == 12345.678f) *(u32x4*)(zr + ZC_QM + col) = pack8(y);
    }
}

#define NSA_TILE_SRC(I, KP, LDK, VP, LDV) do { if ((I) < 2 * nc) { const int kt_ = (I) < nc ? (I) : (I) - nc; KP = kcb + ((size_t)g * 512 + kt_ * 64) * 64; LDK = 64; VP = vctb + (size_t)g * 64 * 512 + kt_ * 64; LDV = 512; } \
    else if ((I) < 2 * nc + cur + 1) { const int s_ = (I) - 2 * nc; KP = zb + (size_t)(s_ * 64) * ZM + ZC_KS + g * 64; LDK = ZM; VP = vst + (size_t)g * 64 * SEQ + s_ * 64; LDV = SEQ; } \
    else { const int w_ = ws0 + (I) - (2 * nc + cur + 1); KP = zb + (size_t)(w_ * 64) * ZM + ZC_KW + g * 64; LDK = ZM; VP = vwt + (size_t)g * 64 * SEQ + w_ * 64; LDV = SEQ; } } while (0)

template <int MODE> __device__ __forceinline__ void tile_softmax(f32x4 (&S)[4], bool rowv, int kfirst, int klo, unsigned kspan, float& l) {
    float ps = 0.f;
#pragma unroll
    for (int st = 0; st < 4; ++st)
#pragma unroll
        for (int j = 0; j < 4; ++j) { float e = __builtin_amdgcn_exp2f(S[st][j]);
            if (MODE == 1) e = rowv ? e : 0.f;
            if (MODE == 2) e = ((unsigned)(kfirst + st * 16 + j - klo) <= kspan) ? e : 0.f;
            S[st][j] = e; ps += e; }
    l += ps;
}

__device__ __forceinline__ void nsa_loadk(const LAS unsigned char* kbuf, int offk0, int offk1, bf16x8 (&ka)[4], bf16x8 (&kb)[4]) {
#pragma unroll
    for (int st = 0; st < 4; ++st) { ka[st] = *(const LAS bf16x8*)(kbuf + offk0 + st * 2048); kb[st] = *(const LAS bf16x8*)(kbuf + offk1 + st * 2048); }
}
__device__ __forceinline__ void nsa_loadv(const LAS unsigned char* vbuf, int offv00, int offv01, int offv10, int offv11, u32x4 (&vf)[2][4]) {
#pragma unroll
    for (int dt = 0; dt < 4; ++dt) { const u32x2 lo0 = *(const LAS u32x2*)(vbuf + offv00 + dt * 2048), hi0 = *(const LAS u32x2*)(vbuf + offv01 + dt * 2048), lo1 = *(const LAS u32x2*)(vbuf + offv10 + dt * 2048), hi1 = *(const LAS u32x2*)(vbuf + offv11 + dt * 2048);
        vf[0][dt].x = lo0.x; vf[0][dt].y = lo0.y; vf[0][dt].z = hi0.x; vf[0][dt].w = hi0.y; vf[1][dt].x = lo1.x; vf[1][dt].y = lo1.y; vf[1][dt].z = hi1.x; vf[1][dt].w = hi1.y; }
}
__device__ __forceinline__ void nsa_scores(const bf16x8 (&ka)[4], const bf16x8 (&kb)[4], bf16x8 q0, bf16x8 q1, f32x4 (&S)[4]) {
    const f32x4 zero4 = {0.f, 0.f, 0.f, 0.f};
#pragma unroll
    for (int st = 0; st < 4; ++st) S[st] = mfma16(ka[st], q0, zero4);
#pragma unroll
    for (int st = 0; st < 4; ++st) S[st] = mfma16(kb[st], q1, S[st]);
}
__device__ __forceinline__ void nsa_pack(const f32x4 (&P)[4], u32x4 (&pf)[2]) {
#pragma unroll
    for (int hf = 0; hf < 2; ++hf) { pf[hf].x = cvt_pk_bf16(P[2 * hf][0], P[2 * hf][1]); pf[hf].y = cvt_pk_bf16(P[2 * hf][2], P[2 * hf][3]); pf[hf].z = cvt_pk_bf16(P[2 * hf + 1][0], P[2 * hf + 1][1]); pf[hf].w = cvt_pk_bf16(P[2 * hf + 1][2], P[2 * hf + 1][3]); }
}
__device__ __forceinline__ void nsa_pv(const u32x4 (&vf)[2][4], const u32x4 (&pf)[2], f32x4 (&O)[4]) {
#pragma unroll
    for (int hf = 0; hf < 2; ++hf)
#pragma unroll
        for (int dt = 0; dt < 4; ++dt) O[dt] = mfma16(__builtin_bit_cast(bf16x8, vf[hf][dt]), __builtin_bit_cast(bf16x8, pf[hf]), O[dt]);
}

__device__ __forceinline__ void nsa_wg_task(bf16_t* zb, const bf16_t* kcb, const bf16_t* vctb, const bf16_t* vst, const bf16_t* vwt, int g, int T0, float* accb, LAS unsigned char* lds, int wave, int lane, int tid) {
    const int n = lane & 15, fq = lane >> 4, ti = n >> 2, h = n & 3, Tmax = T0 + 63;
    f32x4 zero4 = {0.f, 0.f, 0.f, 0.f}; asm volatile("" : "+v"(zero4));
    float NEG = -1e30f, FORCE = 1e9f; asm volatile("" : "+v"(NEG), "+v"(FORCE));
    int t0[2], t[2], tmax[2], nv[2], nvl[2], nproc[2]; bf16x8 q0[2], q1[2]; float gate_c[2], gate_s[2], gate_w[2]; f32x4 O[2][4]; float l[2], il[2];
#pragma unroll
    for (int r = 0; r < 2; ++r) { t0[r] = T0 + wave * 8 + 4 * r; t[r] = t0[r] + ti; tmax[r] = t0[r] + 3;
        const bf16_t* zr = zb + (size_t)t[r] * ZM; const bf16_t* qp = zr + ZC_Q + (g * 4 + h) * 64 + 8 * fq; q0[r] = *(const bf16x8*)qp; q1[r] = *(const bf16x8*)(qp + 32);
        const bf16_t* gp = zr + ZC_G + (g * 4 + h) * 3; gate_c[r] = sigm(bf2f(gp[0])); gate_s[r] = sigm(bf2f(gp[1])); gate_w[r] = sigm(bf2f(gp[2]));
        nv[r] = tmax[r] >= 31 ? ((tmax[r] - 31) >> 4) + 1 : 0; nvl[r] = t[r] >= 31 ? ((t[r] - 31) >> 4) + 1 : 0; nproc[r] = ((nv[r] + 63) >> 6) * 64;
        l[r] = 0.f; il[r] = 0.f;
#pragma unroll
        for (int dt = 0; dt < 4; ++dt) O[r][dt] = zero4; }
    LAS unsigned* wM = (LAS unsigned*)(lds + 131072 + 1024 + wave * 128);
    LAS float* wA = (LAS float*)(lds + 98304 + wave * 4096);
    const int nc = ((((Tmax - 31) >> 4) + 1) + 63) >> 6;
    const int cur = T0 >> 6, ws0 = (T0 - 511 > 0 ? T0 - 511 : 0) >> 6, nw = cur - ws0 + 1, NT = 2 * nc + cur + 1 + nw;
    const int xk_ = ((lane & 15) >> 1) & 7, rb_ = (lane & 15) * 128, offk0 = rb_ + ((fq ^ xk_) << 4), offk1 = rb_ + (((4 + fq) ^ xk_) << 4);
    const int vb_ = rb_ + (fq & 1) * 8, cv_ = fq >> 1, offv00 = vb_ + ((cv_ ^ xk_) << 4), offv01 = vb_ + (((cv_ + 2) ^ xk_) << 4), offv10 = vb_ + (((cv_ + 4) ^ xk_) << 4), offv11 = vb_ + (((cv_ + 6) ^ xk_) << 4);
    const int lrow = tid >> 3, gch = (tid & 7) ^ ((lrow >> 1) & 7);
#define NSA_DMA(I, BUF) do { const bf16_t* kp_; const bf16_t* vp_; int ldk_, ldv_; NSA_TILE_SRC((I), kp_, ldk_, vp_, ldv_); \
    __builtin_amdgcn_global_load_lds((const unsigned*)(kp_ + (size_t)lrow * ldk_ + gch * 8), (LAS unsigned*)(lds + (BUF) * 16384 + wave * 1024), 16, 0, 0); \
    __builtin_amdgcn_global_load_lds((const unsigned*)(vp_ + (size_t)lrow * ldv_ + gch * 8), (LAS unsigned*)(lds + (BUF) * 16384 + 8192 + wave * 1024), 16, 0, 0); } while (0)
    NSA_DMA(0, 0);
    { const int i1_ = 1 < NT ? 1 : NT - 1, i2_ = 2 < NT ? 2 : NT - 1; NSA_DMA(i1_, 1); NSA_DMA(i2_, 2); }
    { const f32x4 z_ = zero4;
#pragma unroll
      for (int q_ = 0; q_ < 4; ++q_) *(LAS f32x4*)(wA + q_ * 256 + lane * 4) = z_; }
    int pb = 0;
    const int NP = (NT + 2) / 3;
    for (int p = 0; p < NP; ++p) {
        asm volatile("s_waitcnt vmcnt(0)" ::: "memory");
        __builtin_amdgcn_s_barrier();
        asm volatile("" ::: "memory");
        { const int ia_ = 3 * p + 3 < NT ? 3 * p + 3 : NT - 1, ib_ = 3 * p + 4 < NT ? 3 * p + 4 : NT - 1, ic_ = 3 * p + 5 < NT ? 3 * p + 5 : NT - 1; const int bn_ = 3 - pb; NSA_DMA(ia_, bn_); NSA_DMA(ib_, bn_ + 1); NSA_DMA(ic_, bn_ + 2); }
        const int pbc = pb; pb = 3 - pb;
#pragma unroll 1
      for (int u = 0; u < 3; ++u) { const int i = 3 * p + u; if (i >= NT) break;
        const LAS unsigned char* kbuf = lds + (pbc + u) * 16384; const LAS unsigned char* vbuf = kbuf + 8192;
        bf16x8 ka[4], kb[4]; u32x4 vf[2][4], pf[2][2]; f32x4 S[4];
        if (i < nc) {
            const int kb0 = i * 64; const bool n0 = kb0 < nv[0], n1 = kb0 < nv[1];
            if (n0 || n1) { nsa_loadk(kbuf, offk0, offk1, ka, kb);
#pragma unroll
                for (int r = 0; r < 2; ++r) if (r == 0 ? n0 : n1) { nsa_scores(ka, kb, q0[r], q1[r], S);
#pragma unroll
                    for (int st = 0; st < 4; ++st)
#pragma unroll
                        for (int j = 0; j < 4; ++j) { const float e = __builtin_amdgcn_exp2f(S[st][j]); l[r] += (kb0 + st * 16 + 4 * fq + j < nvl[r]) ? e : 0.f; } } }
            if (i == nc - 1) {
#pragma unroll
                for (int r = 0; r < 2; ++r) { l[r] = x16sum(l[r]); l[r] = x32sum(l[r]); il[r] = l[r] > 0.f ? 1.0f / l[r] : 0.f; } }
        } else if (i < 2 * nc) {
            const int kb0 = (i - nc) * 64; const bool n0 = kb0 < nv[0], n1 = kb0 < nv[1];
            if (n0 || n1) { nsa_loadk(kbuf, offk0, offk1, ka, kb);
#pragma unroll
                for (int r = 0; r < 2; ++r) if (r == 0 ? n0 : n1) { nsa_scores(ka, kb, q0[r], q1[r], S);
#pragma unroll
                    for (int st = 0; st < 4; ++st)
#pragma unroll
                        for (int j = 0; j < 4; ++j) { const float e = __builtin_amdgcn_exp2f(S[st][j]) * il[r]; S[st][j] = (kb0 + st * 16 + 4 * fq + j < nvl[r]) ? e : 0.f; }
#pragma unroll
                    for (int st = 0; st < 4; ++st) { const int sb = (kb0 >> 2) + 4 * st + fq; const float hb = 0.5f * S[st][3];
                        const float a = quadsum((S[st][0] + S[st][1]) + (S[st][2] + hb)), b = quadsum(hb);
                        if (h == 0) { LAS float* wp = wA + (r * 4 + ti) * 128 + sb; (void)__hip_atomic_fetch_add(wp, a, __ATOMIC_RELAXED, __HIP_MEMORY_SCOPE_WORKGROUP); if (sb + 1 < 128) (void)__hip_atomic_fetch_add(wp + 1, b, __ATOMIC_RELAXED, __HIP_MEMORY_SCOPE_WORKGROUP); } }
                    nsa_pack(S, pf[r]); }
                nsa_loadv(vbuf, offv00, offv01, offv10, offv11, vf);
#pragma unroll
                for (int r = 0; r < 2; ++r) if (r == 0 ? n0 : n1) nsa_pv(vf, pf[r], O[r]); }
            if (i == 2 * nc - 1) {
#pragma unroll
                for (int r = 0; r < 2; ++r) {
#pragma unroll
                    for (int dt = 0; dt < 4; ++dt) { *(f32x4*)(accb + (size_t)t[r] * 1024 + (g * 4 + h) * 64 + dt * 16 + 4 * fq) = O[r][dt] * gate_c[r]; O[r][dt] = zero4; }
                    l[r] = 0.f; }
                if (cur < 16) { if (lane < 32) wM[lane] = (lane & 3) == 0 ? ((2u << cur) - 1u) : 0u;
                } else {
                    LDS_WAIT();
#pragma unroll
                    for (int r = 0; r < 2; ++r) {
#pragma unroll
                        for (int tk = 0; tk < 4; ++tk) { const LAS float* wa = wA + (r * 4 + tk) * 128;
                            unsigned k0, k1;
                            { const int s0 = lane, s1 = lane + 64; const float sc0 = wa[s0], sc1 = wa[s1];
                              const bool f0 = (s0 == 0) || (s0 == cur) || (s0 == cur - 1), f1 = (s1 == cur) || (s1 == cur - 1);
                              k0 = f0 ? __float_as_uint(FORCE) : (s0 <= cur ? __float_as_uint(sc0) : 0u); k1 = f1 ? __float_as_uint(FORCE) : (s1 <= cur ? __float_as_uint(sc1) : 0u); }
                            unsigned T = 0u;
                            for (int bit = 30; bit >= 0; --bit) { const unsigned cand = T | (1u << bit);
                                const int cnt = __builtin_popcountll(__ballot(k0 >= cand)) + __builtin_popcountll(__ballot(k1 >= cand)); T = cnt >= 16 ? cand : T; }
                            const unsigned long long g0 = __ballot(k0 > T), g1 = __ballot(k1 > T), e0 = __ballot(k0 == T), e1 = __ballot(k1 == T);
                            const int need = 16 - (__builtin_popcountll(g0) + __builtin_popcountll(g1));
                            const int rk0 = (int)__builtin_amdgcn_mbcnt_hi((unsigned)(e0 >> 32), __builtin_amdgcn_mbcnt_lo((unsigned)e0, 0u));
                            const int rk1 = __builtin_popcountll(e0) + (int)__builtin_amdgcn_mbcnt_hi((unsigned)(e1 >> 32), __builtin_amdgcn_mbcnt_lo((unsigned)e1, 0u));
                            const bool sel0 = (k0 > T) || (k0 == T && rk0 < need), sel1 = (k1 > T) || (k1 == T && rk1 < need);
                            const unsigned long long lo = __ballot(sel0 && lane <= cur), hi = __ballot(sel1 && lane + 64 <= cur);
                            if (lane == 0) { LAS unsigned* mw = wM + (r * 4 + tk) * 4; mw[0] = (unsigned)lo; mw[1] = (unsigned)(lo >> 32); mw[2] = (unsigned)hi; mw[3] = (unsigned)(hi >> 32); } }
                    }
                    LDS_WAIT();
                }
            }
        } else if (i < 2 * nc + cur + 1) {
            const int s = i - 2 * nc, kb0 = s * 64;
            bool any[2], mine[2], all4[2];
            const unsigned mwd0 = wM[ti * 4 + (s >> 5)], mwd1 = wM[(4 + ti) * 4 + (s >> 5)];
            nsa_loadk(kbuf, offk0, offk1, ka, kb);
#pragma unroll
            for (int r = 0; r < 2; ++r) { const unsigned mwd = r == 0 ? mwd0 : mwd1; mine[r] = ((mwd >> (s & 31)) & 1u) != 0u; const unsigned long long bal = __ballot(mine[r]); any[r] = bal != 0ull && kb0 <= tmax[r]; all4[r] = bal == ~0ull; }
            if (any[0] || any[1]) {
#pragma unroll
                for (int r = 0; r < 2; ++r) if (any[r]) { nsa_scores(ka, kb, q0[r], q1[r], S);
                    if (kb0 + 63 <= t0[r]) { if (all4[r]) tile_softmax<0>(S, true, 0, 0, 0u, l[r]); else tile_softmax<1>(S, mine[r], 0, 0, 0u, l[r]); }
                    else tile_softmax<2>(S, false, kb0 + 4 * fq, mine[r] ? 0 : 0x40000000, (unsigned)t[r], l[r]);
                    nsa_pack(S, pf[r]); }
                nsa_loadv(vbuf, offv00, offv01, offv10, offv11, vf);
#pragma unroll
                for (int r = 0; r < 2; ++r) if (any[r]) nsa_pv(vf, pf[r], O[r]); }
            if (s == cur) {
#pragma unroll
                for (int r = 0; r < 2; ++r) { l[r] = x16sum(l[r]); l[r] = x32sum(l[r]); const float sc = (l[r] > 0.f ? 1.0f / l[r] : 0.f) * gate_s[r];
#pragma unroll
                    for (int dt = 0; dt < 4; ++dt) { f32x4* ap = (f32x4*)(accb + (size_t)t[r] * 1024 + (g * 4 + h) * 64 + dt * 16 + 4 * fq); *ap = *ap + O[r][dt] * sc; O[r][dt] = zero4; }
                    l[r] = 0.f; } }
        } else {
            const int kb0 = (ws0 + i - (2 * nc + cur + 1)) * 64;
            bool need[2];
#pragma unroll
            for (int r = 0; r < 2; ++r) need[r] = kb0 <= tmax[r] && kb0 + 63 + 512 > t0[r];
            if (need[0] || need[1]) { nsa_loadk(kbuf, offk0, offk1, ka, kb);
#pragma unroll
                for (int r = 0; r < 2; ++r) if (need[r]) { nsa_scores(ka, kb, q0[r], q1[r], S);
                    if (kb0 + 512 > tmax[r] && kb0 + 63 <= t0[r]) tile_softmax<0>(S, true, 0, 0, 0u, l[r]);
                    else tile_softmax<2>(S, false, kb0 + 4 * fq, t[r] - 511, 511u, l[r]);
                    nsa_pack(S, pf[r]); }
                nsa_loadv(vbuf, offv00, offv01, offv10, offv11, vf);
#pragma unroll
                for (int r = 0; r < 2; ++r) if (need[r]) nsa_pv(vf, pf[r], O[r]); }
        }
      }
    }
    asm volatile("s_waitcnt vmcnt(0)" ::: "memory"); __builtin_amdgcn_s_barrier(); asm volatile("" ::: "memory");
#undef NSA_DMA
#pragma unroll
    for (int r = 0; r < 2; ++r) { l[r] = x16sum(l[r]); l[r] = x32sum(l[r]);
        const float sc = (l[r] > 0.f ? 1.0f / l[r] : 0.f) * gate_w[r];
#pragma unroll
        for (int dt = 0; dt < 4; ++dt) O[r][dt] = *(const f32x4*)(accb + (size_t)t[r] * 1024 + (g * 4 + h) * 64 + dt * 16 + 4 * fq) + O[r][dt] * sc;
        bf16_t* op = zb + (size_t)t[r] * ZM + ZC_Q + (g * 4 + h) * 64 + 4 * fq;
#pragma unroll
        for (int dt = 0; dt < 4; ++dt) { u32x2 w; w.x = cvt_pk_bf16(O[r][dt][0], O[r][dt][1]); w.y = cvt_pk_bf16(O[r][dt][2], O[r][dt][3]); *(u32x2*)(op + dt * 16) = w; } }
}

__device__ __forceinline__ void mem_task(bf16_t* zb, const bf16_t* kvm_b, const bf16_t* vmt_b, int hm, int t0, int lane, bool do_store) {
    const int n = lane & 15, fq = lane >> 4;
    bf16_t* qp = zb + (size_t)(t0 + n) * ZM + ZC_QM + hm * 256;
    bf16x8 qf[8];
#pragma unroll
    for (int kk = 0; kk < 8; ++kk) qf[kk] = *(const bf16x8*)(qp + kk * 32 + 8 * fq);
    f32x4 zero4 = {0.f, 0.f, 0.f, 0.f}; asm volatile("" : "+v"(zero4));
    f32x4 s[16];
    const bf16_t* kbase = kvm_b + (size_t)(8 * (n >> 2) + (n & 3)) * 2048 + hm * 256 + 8 * fq;
    bf16x8 kfr[3][8];
#pragma unroll
    for (int kk = 0; kk < 8; ++kk) kfr[0][kk] = *(const bf16x8*)(kbase + kk * 32);
    { const bf16_t* kp = kbase + (size_t)4 * 2048;
#pragma unroll
      for (int kk = 0; kk < 8; ++kk) kfr[1][kk] = *(const bf16x8*)(kp + kk * 32); }
#pragma unroll
    for (int kt = 0; kt < 16; ++kt) {
        if (kt + 2 < 16) { const bf16_t* kp = kbase + (size_t)(((kt + 2) >> 1) * 32 + 4 * ((kt + 2) & 1)) * 2048;
#pragma unroll
            for (int kk = 0; kk < 8; ++kk) kfr[(kt + 2) % 3][kk] = *(const bf16x8*)(kp + kk * 32); }
        f32x4 acc = zero4;
#pragma unroll
        for (int kk = 0; kk < 8; ++kk) acc = mfma16(kfr[kt % 3][kk], qf[kk], acc);
        s[kt] = acc; }
    float l = 0.f;
#pragma unroll
    for (int kt = 0; kt < 16; ++kt)
#pragma unroll
        for (int j = 0; j < 4; ++j) { s[kt][j] = __builtin_amdgcn_exp2f(s[kt][j]); l += s[kt][j]; }
    l = x16sum(l); l = x32sum(l);
    const float il = 1.0f / l;
    bf16x8 pf[8];
#pragma unroll
    for (int kp = 0; kp < 8; ++kp) { u32x4 w; w.x = cvt_pk_bf16(s[2 * kp][0], s[2 * kp][1]); w.y = cvt_pk_bf16(s[2 * kp][2], s[2 * kp][3]); w.z = cvt_pk_bf16(s[2 * kp + 1][0], s[2 * kp + 1][1]); w.w = cvt_pk_bf16(s[2 * kp + 1][2], s[2 * kp + 1][3]); pf[kp] = __builtin_bit_cast(bf16x8, w); }
    const bf16_t* vbase = vmt_b + (size_t)(hm * 256 + n) * 256 + 8 * fq;
    bf16x8 vfr[3][8];
#pragma unroll
    for (int kp = 0; kp < 8; ++kp) vfr[0][kp] = *(const bf16x8*)(vbase + kp * 32);
    { const bf16_t* vp = vbase + (size_t)16 * 256;
#pragma unroll
      for (int kp = 0; kp < 8; ++kp) vfr[1][kp] = *(const bf16x8*)(vp + kp * 32); }
#pragma unroll
    for (int dt = 0; dt < 16; ++dt) {
        if (dt + 2 < 16) { const bf16_t* vp = vbase + (size_t)((dt + 2) * 16) * 256;
#pragma unroll
            for (int kp = 0; kp < 8; ++kp) vfr[(dt + 2) % 3][kp] = *(const bf16x8*)(vp + kp * 32); }
        f32x4 acc = zero4;
#pragma unroll
        for (int kp = 0; kp < 8; ++kp) acc = mfma16(vfr[dt % 3][kp], pf[kp], acc);
        u32x2 w; w.x = cvt_pk_bf16(acc[0] * il, acc[1] * il); w.y = cvt_pk_bf16(acc[2] * il, acc[3] * il); if (do_store || acc[0] == 12345.678f) *(u32x2*)(qp + dt * 16 + 4 * fq) = w; }
}

struct Args { const float* in[29]; float* out; unsigned char* ws; int ph_lo, ph_hi; };
enum { I_X = 0, I_MEM, I_F1N, I_F1G, I_F1U, I_F1D, I_MIXN, I_MEMNORM, I_WIN, I_CONVW, I_GQ, I_GKC, I_GKS, I_GKW, I_PEK, I_W1K, I_W2K, I_PEV, I_W1V, I_W2V, I_WMKV, I_GMQ, I_GMK, I_WBR, I_WO, I_F2N, I_F2G, I_F2U, I_F2D };

#define XB_TMO      128
#define XB_XCNT(j)  (256  + 64 * (j))
#define XB_XSUB(j)  (1280 + 64 * (j))
#define XB_XGEN(j)  (2304 + 64 * (j))
#define XB_TOP      3328
#define XB_TOPGEN   3392
#define XCD_BAR_WORDS 3456
#define XB_SPIN_CAP (1u << 18)

__device__ __forceinline__ unsigned xb_ld(unsigned* p)              { return __hip_atomic_load(p, __ATOMIC_RELAXED, __HIP_MEMORY_SCOPE_AGENT); }
__device__ __forceinline__ unsigned xb_add(unsigned* p, unsigned v) { return __hip_atomic_fetch_add(p, v, __ATOMIC_RELAXED, __HIP_MEMORY_SCOPE_AGENT); }
__device__ __forceinline__ unsigned xb_xcc_id() { return (unsigned)__builtin_amdgcn_s_getreg((3 << 11) | 20) & 0xFu; }
#define XB_SPIN(cond, bar) do { unsigned _sp = 0; while (cond) { __builtin_amdgcn_s_sleep(1); \
    if ((++_sp & 255u) == 0u) { if (xb_ld(&(bar)[XB_TMO])) break; if (_sp > XB_SPIN_CAP) { atomicAdd(&(bar)[XB_TMO], 1u); break; } } } } while (0)

struct XcdBarrier {
    unsigned* bar; unsigned x;
    volatile LAS unsigned* st;
};

__device__ __forceinline__ XcdBarrier xcd_barrier_post(unsigned* bar, volatile LAS unsigned* st) {
    XcdBarrier b; b.bar = bar; b.x = xb_xcc_id(); b.st = st;
    if (threadIdx.x == 0) (void)xb_add(&bar[XB_XCNT(b.x)], 1u);
    return b;
}
__device__ __forceinline__ void xcd_barrier_complete(unsigned* bar, unsigned x, unsigned& nloc, unsigned& nx) {
    const unsigned G = gridDim.x * gridDim.y * gridDim.z;
    unsigned sum, cnt, mine, sp = 0u;
    for (;;) {
        sum = 0u; cnt = 0u; mine = 0u;
#pragma unroll
        for (unsigned j = 0; j < 16; ++j) { const unsigned c = xb_ld(&bar[XB_XCNT(j)]); sum += c; cnt += (c > 0u) ? 1u : 0u; mine = (j == x) ? c : mine; }
        if (sum == G) break;
        __builtin_amdgcn_s_sleep(1);
        if ((++sp & 255u) == 0u) { if (xb_ld(&bar[XB_TMO])) break; if (sp > XB_SPIN_CAP) { atomicAdd(&bar[XB_TMO], 1u); break; } }
    }
    nloc = mine > 0u ? mine : 1u; nx = cnt > 0u ? cnt : 1u;
}

__device__ __forceinline__ void xcd_barrier(const XcdBarrier& b, bool is_thread0) {
    asm volatile("s_waitcnt vmcnt(0)" ::: "memory");
    __syncthreads();
    if (is_thread0) {
        unsigned* bar = b.bar;
        __builtin_amdgcn_s_waitcnt(0);
        unsigned nloc = b.st[0], nx = b.st[1];
        if (nloc == 0u) { xcd_barrier_complete(bar, b.x, nloc, nx); b.st[0] = nloc; b.st[1] = nx; }
        const unsigned old = xb_add(&bar[XB_XSUB(b.x)], 1u);
        const unsigned gen = old / nloc;
        if (old + 1u == (gen + 1u) * nloc) {
            __builtin_amdgcn_fence(__ATOMIC_RELEASE, "agent");
            asm volatile("s_waitcnt vmcnt(0)" ::: "memory");
            const unsigned og = xb_add(&bar[XB_TOP], 1u);
            const unsigned tg = og / nx;
            if (og + 1u == (tg + 1u) * nx) xb_add(&bar[XB_TOPGEN], 1u);
            else XB_SPIN(xb_ld(&bar[XB_TOPGEN]) == tg, bar);
            __builtin_amdgcn_fence(__ATOMIC_ACQUIRE, "agent");
            xb_add(&bar[XB_XGEN(b.x)], 1u);
            asm volatile("s_waitcnt vmcnt(0)" ::: "memory");
        } else {
            XB_SPIN(xb_ld(&bar[XB_XGEN(b.x)]) == gen, bar);
            __builtin_amdgcn_fence(__ATOMIC_ACQUIRE, "agent");
            asm volatile("s_waitcnt vmcnt(0)" ::: "memory");
        }
    }
    __syncthreads();
}

__device__ __forceinline__ int fresh_lane() { unsigned m_ = ~0u; asm volatile("" : "+s"(m_)); return (int)__builtin_amdgcn_mbcnt_hi(m_, __builtin_amdgcn_mbcnt_lo(m_, 0u)); }
__device__ __forceinline__ const void* ldp(LAS unsigned long long* tab, int i) { const unsigned long long v = tab[i]; const unsigned lo = __builtin_amdgcn_readfirstlane((unsigned)v), hi = __builtin_amdgcn_readfirstlane((unsigned)(v >> 32)); return (const void*)(const __attribute__((address_space(1))) void*)(((unsigned long long)hi << 32) | lo); }
#define INP(i) ((const float*)ldp(tab, (i)))
__global__ void __launch_bounds__(512, 2) mega(Args a) {
    extern __shared__ __attribute__((aligned(16))) unsigned char lds_raw[];
    LAS unsigned char* lds = (LAS unsigned char*)lds_raw;
    const int tid0 = threadIdx.x; const int wave0 = __builtin_amdgcn_readfirstlane(tid0 >> 6);
    LAS unsigned long long* tab = (LAS unsigned long long*)(lds + 131072);
    if (tid0 == 0) {
        tab[0] = (unsigned long long)a.in[0]; tab[1] = (unsigned long long)a.in[1]; tab[2] = (unsigned long long)a.in[2]; tab[3] = (unsigned long long)a.in[3]; tab[4] = (unsigned long long)a.in[4];
        tab[5] = (unsigned long long)a.in[5]; tab[6] = (unsigned long long)a.in[6]; tab[7] = (unsigned long long)a.in[7]; tab[8] = (unsigned long long)a.in[8]; tab[9] = (unsigned long long)a.in[9];
        tab[10] = (unsigned long long)a.in[10]; tab[11] = (unsigned long long)a.in[11]; tab[12] = (unsigned long long)a.in[12]; tab[13] = (unsigned long long)a.in[13]; tab[14] = (unsigned long long)a.in[14];
        tab[15] = (unsigned long long)a.in[15]; tab[16] = (unsigned long long)a.in[16]; tab[17] = (unsigned long long)a.in[17]; tab[18] = (unsigned long long)a.in[18]; tab[19] = (unsigned long long)a.in[19];
        tab[20] = (unsigned long long)a.in[20]; tab[21] = (unsigned long long)a.in[21]; tab[22] = (unsigned long long)a.in[22]; tab[23] = (unsigned long long)a.in[23]; tab[24] = (unsigned long long)a.in[24];
        tab[25] = (unsigned long long)a.in[25]; tab[26] = (unsigned long long)a.in[26]; tab[27] = (unsigned long long)a.in[27]; tab[28] = (unsigned long long)a.in[28];
        tab[29] = (unsigned long long)a.out; tab[30] = (unsigned long long)a.ws; tab[31] = ((unsigned long long)(unsigned)a.ph_hi << 32) | (unsigned)a.ph_lo;
        ((volatile LAS unsigned*)(lds + 131072 + 512))[0] = 0u; ((volatile LAS unsigned*)(lds + 131072 + 512))[1] = 0u;
    }
    __syncthreads();
    if (a.ph_hi - a.ph_lo > 1) (void)xcd_barrier_post((unsigned*)a.ws, (volatile LAS unsigned*)(lds + 131072 + 512));
    cg::grid_group grid = cg::this_grid();

    for (int ph = a.ph_lo; ; ++ph) {
        asm volatile("" ::: "memory");
        const int ph_hi = __builtin_amdgcn_readfirstlane((int)(tab[31] >> 32));
        if (ph >= ph_hi) break;
        int wave_ = wave0; asm volatile("" : "+s"(wave_)); const int wave = wave_;
        const int lane = fresh_lane();
        int G_ = gridDim.x, cb_ = blockIdx.x; asm volatile("" : "+s"(G_), "+s"(cb_)); const int G = G_, cb = cb_, gw = cb * 8 + wave, NGW = G * 8;
        unsigned char* ws = (unsigned char*)ldp(tab, 30); float* const OUTP = (float*)ldp(tab, 29);
        bf16_t* const WIN_T = (bf16_t*)(ws + WS_WIN); bf16_t* const WMK_T = (bf16_t*)(ws + WS_WMK); bf16_t* const WBR_T = (bf16_t*)(ws + WS_WBR); bf16_t* const WO_T = (bf16_t*)(ws + WS_WO);
        bf16_t* const WC1_T = (bf16_t*)(ws + WS_WC1); float* const BIASC = (float*)(ws + WS_BIASC); bf16_t* const MEMN = (bf16_t*)(ws + WS_MEMN); bf16_t* const KVM = (bf16_t*)(ws + WS_KVM); bf16_t* const VMT = (bf16_t*)(ws + WS_VMT);
        bf16_t* const WGU1 = (bf16_t*)(ws + WS_WGU1); bf16_t* const WD1 = (bf16_t*)(ws + WS_WD1); bf16_t* const WGU2 = (bf16_t*)(ws + WS_WGU2); bf16_t* const WD2 = (bf16_t*)(ws + WS_WD2);
        bf16_t* const H = (bf16_t*)(ws + WS_H); float* const MF = (float*)(ws + WS_MF); bf16_t* const ACT = (bf16_t*)(ws + WS_ACT);
        bf16_t* const ZMAIN = (bf16_t*)(ws + WS_ZMAIN); bf16_t* const ZGATE = (bf16_t*)(ws + WS_ZGATE); bf16_t* const VST = (bf16_t*)(ws + WS_VST); bf16_t* const VWT = (bf16_t*)(ws + WS_VWT);
        bf16_t* const HID = (bf16_t*)(ws + WS_HID); bf16_t* const KC = (bf16_t*)(ws + WS_KC); bf16_t* const VCT = (bf16_t*)(ws + WS_VCT);
        int kind, b = 0, f = 0;
        if (ph < 4) kind = ph; else if (ph < 16) { b = (ph - 4) / 6; kind = 4 + (ph - 4) % 6; } else { f = 1; kind = ph == 16 ? 3 : (ph == 17 ? 1 : 2); }
        if (kind == 9) kind = 2;
        const size_t boff = (size_t)b * SEQ;

#ifndef PROBE_PRO
#define PROBE_PRO 1
#endif
#ifndef PROBE_GU
#define PROBE_GU 1
#endif
#ifndef PROBE_CMP
#define PROBE_CMP 1
#endif
#ifndef PROBE_TOK
#define PROBE_TOK 1
#endif
#ifndef PROBE_VTR
#define PROBE_VTR 1
#endif
#ifndef PROBE_CL2
#define PROBE_CL2 1
#endif
#ifndef PROBE_Z
#define PROBE_Z 1
#endif
#ifndef PROBE_MERGE
#define PROBE_MERGE 1
#endif
#ifndef PROBE_NORM
#define PROBE_NORM 1
#endif
#ifndef PROBE_SYNC
#define PROBE_SYNC 1
#endif
#ifndef PROBE_NSA_SKIPC
#define PROBE_NSA_SKIPC 0
#endif
#ifndef PROBE_NSA
#define PROBE_NSA 1
#endif
#ifndef PROBE_C2
#define PROBE_C2 1
#endif
        if (kind == 0) for (int prep_ = 0; prep_ < PROBE_PRO; ++prep_) {
            LAS float* scr = (LAS float*)(lds + wave * 16384);
            int total = 0;
#define SEGN(ncols, K) (((K) / 64) * (((ncols) + 31) / 32))
            constexpr int N_F = SEGN(5632, 2048), N_D = SEGN(2048, 5632);
            constexpr int NIT = 2 * N_F + N_D + SEGN(1024, 2048) * 5 + SEGN(1536, 2048) + SEGN(48, 2048) + SEGN(6144, 2048) + SEGN(2048, 2048) + 2 * SEGN(256, 2048);
            (void)total;
            for (int it = gw; it < NIT; it += NGW) {
                int r = it;
#define SEG(W, ldw, col0, ncols, K, WT, row0, mode) { constexpr int ni_ = SEGN(ncols, K); if (r < ni_) { tr_item((W), (ldw), (col0), (ncols), (K), (WT), (row0), (mode), scr, r, lane); continue; } r -= ni_; }
                SEG(INP(I_F1G), DFF, 0, 5632, 2048, WGU1, 0, 1)
                SEG(INP(I_F1U), DFF, 0, 5632, 2048, WGU1, 128, 1)
                SEG(INP(I_F1D), DM, 0, 2048, 5632, WD1, 0, 0)
                SEG(INP(I_WIN), 12848, 0, 1024, 2048, WIN_T, ZC_B, 0)
                SEG(INP(I_WIN), 12848, 3072, 1024, 2048, WIN_T, ZC_Q, 0)
                SEG(INP(I_WIN), 12848, 5680, 1024, 2048, WIN_T, ZC_QM, 0)
                SEG(INP(I_WIN), 12848, 1024, 1024, 2048, WIN_T, ZC_C, 0)
                SEG(INP(I_WIN), 12848, 2048, 1024, 2048, WIN_T, ZC_U, 0)
                SEG(INP(I_WIN), 12848, 4096, 1536, 2048, WIN_T, ZC_KC, 0)
                SEG(INP(I_WIN), 12848, 5632, 48, 2048, WIN_T, ZC_G, 0)
                SEG(INP(I_WIN), 12848, 6704, 6144, 2048, WIN_T, ZM, 0)
                SEG(INP(I_WMKV), 2048, 0, 2048, 2048, WMK_T, 0, 0)
                SEG(INP(I_W1K), 256, 0, 256, 2048, WC1_T, 0, 0)
                SEG(INP(I_W1V), 256, 0, 256, 2048, WC1_T, 256, 0)
            }
            { u32x4* p = (u32x4*)(WIN_T + (size_t)(ZC_G + 48) * 2048); const int n16 = (ZM - ZC_G - 48) * 2048 * 2 / 16; const u32x4 z4 = {0u, 0u, 0u, 0u};
                for (int i = cb * 512 + ((wave << 6) | lane); i < n16; i += G * 512) p[i] = z4; }
            for (int m = gw; m < MTOK; m += NGW) rms_row(INP(I_X) + (size_t)m * DM, INP(I_F1N), H + (size_t)m * DM, lane);
            for (int m = gw; m < 512; m += NGW) rms_row(INP(I_MEM) + (size_t)m * DM, INP(I_MEMNORM), MEMN + (size_t)m * DM, lane);
            for (int tk = gw; tk < 512; tk += NGW) { const int kv = tk >> 8, j = tk & 255; const float* pe = INP(kv ? I_PEV : I_PEK); const float* w1 = INP(kv ? I_W1V : I_W1K);
                float acc = 0.f;
#pragma unroll 8
                for (int i = 0; i < 32; ++i) { const int k = lane + 64 * i; acc += pe[k] * w1[(size_t)k * 256 + j]; }
                acc = wave_sum(acc);
                if (lane == 0) BIASC[kv * 256 + j] = acc; }
        }
        else if (kind == 1) {
            pg8::Gemm g{H, f ? WGU2 : WGU1, MTOK, 2 * DFF, DM, DM, 0, DM}; pg8::Order S; S.init(MTOK, 2 * DFF, G, cb, 0);
            pg8::EpiSwiGLU E{ACT, DFF};
            for (int prep_ = 0; prep_ < PROBE_GU; ++prep_) pg8::gemm_phase<pg8::EpiSwiGLU, pg8::Order, true, true>(lds, g, S, E, wave);
        }
        else if (kind == 2) {
            const bool wo = (ph >= 4 && ph < 16);
            pg8::Gemm g{wo ? H + boff * DM : ACT, wo ? WO_T : (f ? WD2 : WD1), wo ? SEQ : MTOK, DM, wo ? DM : DFF, wo ? DM : DFF, 0, wo ? DM : DFF};
            pg8::Order S; S.init(g.M, DM, G, cb, 0);
            const float* base = wo ? OUTP + boff * DM : (f ? OUTP : INP(I_X));
            pg8::EpiResid E{base, wo ? OUTP + boff * DM : OUTP, DM, wo ? 1.0f : 0.5f};
            pg8::gemm_phase<pg8::EpiResid, pg8::Order, true, true>(lds, g, S, E, wave);
        }
        else if (kind == 3) {
            const float* gain = INP(f ? I_F2N : I_MIXN);
            for (int prep_ = 0; prep_ < PROBE_NORM; ++prep_) for (int m = gw; m < MTOK; m += NGW) rms_row(OUTP + (size_t)m * DM, gain, H + (size_t)m * DM, lane);
        }
        else if (kind == 4) {
            const int nrep = b == 0 ? 2 : 1;
            for (int rep = 0; rep < nrep; ++rep) {
                pg8::Gemm g{rep ? MEMN : H + boff * DM, rep ? WMK_T : WIN_T, rep ? 512 : SEQ, rep ? 2048 : 13056, DM, DM, 0, DM}; pg8::Order S; S.init(g.M, g.N, G, rep ? (cb + G - 96) % G : cb, 0);
                pg8::EpiStore E{rep ? KVM : ZMAIN, rep ? 2048 : ZM, rep ? 8 : NZ0, ZGATE, ZG};
                for (int prep_ = 0; prep_ < PROBE_Z; ++prep_) pg8::gemm_phase<pg8::EpiStore, pg8::Order, true, true>(lds, g, S, E, wave);
            }
            if (G != 256 || cb >= 112) { LAS float* scr = (LAS float*)(lds + wave * 16384); const int lane = fresh_lane(); const int gw3 = G == 256 ? (cb - 112) * 8 + wave : gw, NGW3 = G == 256 ? (G - 112) * 8 : NGW;
                if (b == 0) { constexpr int NITZ = SEGN(5632, 2048) + 3 * SEGN(2048, 1024) + SEGN(2048, 2048);
                    for (int it = gw3; it < NITZ; it += NGW3) { int r = it;
                        SEG(INP(I_WBR), 2048, 0, 2048, 1024, WBR_T, 0, 0)
                        SEG(INP(I_WBR) + (size_t)1024 * 2048, 2048, 0, 2048, 1024, WBR_T, 2048, 0)
                        SEG(INP(I_WBR) + (size_t)2 * 1024 * 2048, 2048, 0, 2048, 1024, WBR_T, 4096, 0)
                        SEG(INP(I_WO), 2048, 0, 2048, 2048, WO_T, 0, 0)
                        SEG(INP(I_F2G), DFF, 0, 5632, 2048, WGU2, 0, 1)
                    } }
                else { constexpr int NITZ = SEGN(5632, 2048) + SEGN(2048, 5632);
                    for (int it = gw3; it < NITZ; it += NGW3) { int r = it;
                        SEG(INP(I_F2U), DFF, 0, 5632, 2048, WGU2, 128, 1)
                        SEG(INP(I_F2D), DM, 0, 2048, 5632, WD2, 0, 0)
                    } } }
        }
        else if (kind == 5) {
            {
                pg8::Gemm g{ZMAIN, WC1_T, 2048, 512, DM, ZM, 1, DM}; pg8::Order S; S.init(2048, 512, G, cb, 2); S.a1off = ZC_KC * 2; S.a2off = ZC_VC * 2;
                pg8::EpiCmp E{HID, BIASC, 2044};
                for (int prep_ = 0; prep_ < PROBE_CMP; ++prep_) pg8::gemm_phase<pg8::EpiCmp, pg8::Order, true, true>(lds, g, S, E, wave);
            }
            const int lane = fresh_lane();
            const bool split_ = G > 32; const int gw2 = split_ ? (cb - 16) * 8 + wave : gw, NGW2 = split_ ? (G - 16) * 8 : NGW;
            if (!split_ || cb >= 16) {
            for (int prep_ = 0; prep_ < PROBE_TOK; ++prep_) for (int t = gw2; t < SEQ; t += NGW2) tok_prep(ZMAIN, t, INP(I_CONVW), INP(I_GQ), INP(I_GKS), INP(I_GKW), INP(I_GMQ), lane, prep_ == PROBE_TOK - 1);
            for (int prep_ = 0; prep_ < PROBE_VTR; ++prep_) for (int it = gw2; it < 128 * 64; it += NGW2) { const int tg = it >> 6, ch = it & 63, t = tg * 64 + lane; const int src = (ch < 32 ? ZC_VS : ZC_VW) + (ch & 31) * 8;
                float v[8]; unpack8(*(const u32x4*)(ZMAIN + (size_t)t * ZM + src), v); bf16_t* dst = (ch < 32 ? VST : VWT) + (size_t)((ch & 31) * 8) * SEQ + t;
                const u32x4 w = *(const u32x4*)(ZMAIN + (size_t)t * ZM + src);
                dst[0 * SEQ] = (bf16_t)(w.x & 0xffffu); dst[1 * SEQ] = (bf16_t)(w.x >> 16); dst[2 * SEQ] = (bf16_t)(w.y & 0xffffu); dst[3 * SEQ] = (bf16_t)(w.y >> 16);
                dst[4 * (size_t)SEQ] = (bf16_t)(w.z & 0xffffu); dst[5 * (size_t)SEQ] = (bf16_t)(w.z >> 16); dst[6 * (size_t)SEQ] = (bf16_t)(w.w & 0xffffu); dst[7 * (size_t)SEQ] = (bf16_t)(w.w >> 16); (void)v; }
            if (b == 0) {
                const float* gk = INP(I_GMK);
                for (int it = gw2; it < 512 * 4; it += NGW2) { const int r = it >> 2, hh = it & 3; bf16_t* p = KVM + (size_t)r * 2048 + hh * 256 + lane * 4; const u32x2 w = *(const u32x2*)p;
                    const float v0 = bflo(w.x), v1 = bfhi(w.x), v2 = bflo(w.y), v3 = bfhi(w.y);
                    const float rr = 1.0f / sqrtf(wave_sum(v0 * v0 + v1 * v1 + v2 * v2 + v3 * v3) * (1.0f / 256.0f) + EPS);
                    u32x2 o; o.x = cvt_pk_bf16(v0 * rr * gk[lane * 4], v1 * rr * gk[lane * 4 + 1]); o.y = cvt_pk_bf16(v2 * rr * gk[lane * 4 + 2], v3 * rr * gk[lane * 4 + 3]); *(u32x2*)p = o; }
                for (int it = gw2; it < 8 * 128; it += NGW2) { const int rg = it >> 7, ch = it & 127, r = rg * 64 + lane, bb = r >> 8, mm = r & 255;
                    const u32x4 w = *(const u32x4*)(KVM + (size_t)r * 2048 + 1024 + ch * 8); const int hh = ch >> 5, d0 = (ch & 31) * 8;
                    bf16_t* dst = VMT + ((size_t)(bb * 4 + hh) * 256 + d0) * 256 + mm;
                    dst[0] = (bf16_t)(w.x & 0xffffu); dst[256] = (bf16_t)(w.x >> 16); dst[512] = (bf16_t)(w.y & 0xffffu); dst[768] = (bf16_t)(w.y >> 16);
                    dst[1024] = (bf16_t)(w.z & 0xffffu); dst[1280] = (bf16_t)(w.z >> 16); dst[1536] = (bf16_t)(w.w & 0xffffu); dst[1792] = (bf16_t)(w.w >> 16); }
            }
            }
        }
        else if (kind == 6) {
            for (int prep_ = 0; prep_ < PROBE_CL2; ++prep_) for (int it = gw; it < 2048 * 2; it += NGW) { const int R = it >> 1, kv = it & 1, i = R >> 2, gg = R & 3;
                float acc = 0.f;
                if (R < 2044) {
                    const bf16_t* hr = HID + ((size_t)kv * 2048 + R) * 256; const u32x2 hw = *(const u32x2*)(hr + lane * 4);
                    const float h0 = bflo(hw.x), h1 = bfhi(hw.x), h2 = bflo(hw.y), h3 = bfhi(hw.y); const float* w2 = INP(kv ? I_W2V : I_W2K) + lane;
#pragma unroll 16
                    for (int jj = 0; jj < 64; ++jj) {
                        acc += __int_as_float(__builtin_amdgcn_readlane(__float_as_int(h0), jj)) * w2[(jj * 4 + 0) * 64];
                        acc += __int_as_float(__builtin_amdgcn_readlane(__float_as_int(h1), jj)) * w2[(jj * 4 + 1) * 64];
                        acc += __int_as_float(__builtin_amdgcn_readlane(__float_as_int(h2), jj)) * w2[(jj * 4 + 2) * 64];
                        acc += __int_as_float(__builtin_amdgcn_readlane(__float_as_int(h3), jj)) * w2[(jj * 4 + 3) * 64]; }
                }
                if (kv == 0) { const float rr = 1.0f / sqrtf(wave_sum(acc * acc) * (1.0f / 64.0f) + EPS); const float y = acc * rr * INP(I_GKC)[lane];
                    KC[((size_t)gg * 512 + i) * 64 + lane] = (bf16_t)(cvt_pk_bf16(y, 0.f) & 0xffffu); }
                else VCT[((size_t)gg * 64 + lane) * 512 + i] = (bf16_t)(cvt_pk_bf16(acc, 0.f) & 0xffffu);
            }
            for (int prep_ = 0; prep_ < PROBE_C2; ++prep_) for (int it = gw; it < (SEQ / 16) * 4; it += NGW) { const int hm = it & 3, t0 = (it >> 2) * 16;
                mem_task(ZMAIN, KVM + (size_t)b * 256 * 2048, VMT + (size_t)b * 4 * 256 * 256, hm, t0, lane, prep_ == PROBE_C2 - 1); }
        }
        else if (kind == 7) {
            for (int wt = cb; wt < (SEQ / 64) * 4; wt += G) { const int gg = wt & 3; int tl = wt >> 2;
                if (G == 256) { const int j = cb >> 2, r = (wt >> 8) ^ (j & 1); tl = r == 0 ? j : 127 - j; }
                const int T0 = tl * 64;
                const int ln_ = fresh_lane(); nsa_wg_task(ZMAIN, KC, VCT, VST, VWT, gg, T0, MF, lds, wave, ln_, (wave << 6) | ln_); }
        }
        else if (kind == 8) {
            pg8::Gemm g{ZMAIN, WBR_T, SEQ, 6144, 1024, ZM, 0, 1024}; pg8::Order S; S.init(SEQ, 6144, G, cb, 1);
            pg8::EpiMerge E{ZGATE, ZG, MF, H + boff * DM};
            for (int prep_ = 0; prep_ < PROBE_MERGE; ++prep_) pg8::gemm_phase<pg8::EpiMerge, pg8::Order, true, true>(lds, g, S, E, wave);
        }
        if (ph + 1 < ph_hi) for (int prep_ = 0; prep_ < PROBE_SYNC; ++prep_) { if (ph_hi > 1000) grid.sync(); else { XcdBarrier gb_; gb_.bar = (unsigned*)ldp(tab, 30); gb_.x = xb_xcc_id(); gb_.st = (volatile LAS unsigned*)(lds + 131072 + 512); xcd_barrier(gb_, wave == 0 && fresh_lane() == 0); } }
    }
}

#ifndef MK_MULTI
#define MK_MULTI 0
#endif
extern "C" void kernel_launch(void* const* d_in, const int* in_sizes, int n_in, void* d_out, int out_size, void* d_ws, size_t ws_size, hipStream_t stream) {
    static int grid = 0;
    if (grid == 0) {
        if (n_in != 29 || in_sizes[0] != MTOK * DM || out_size != MTOK * DM || ws_size < WS_END) { fprintf(stderr, "kernel_launch: unexpected shapes (n_in %d, in0 %d, out %d, ws %zu)\n", n_in, n_in > 0 ? in_sizes[0] : -1, out_size, ws_size); grid = -1; return; }
        int dev = 0, cus = 0, per_cu = 0;
        if (hipGetDevice(&dev) != hipSuccess || hipDeviceGetAttribute(&cus, hipDeviceAttributeMultiprocessorCount, dev) != hipSuccess) { grid = -1; return; }
        if (hipFuncSetAttribute((const void*)mega, hipFuncAttributeMaxDynamicSharedMemorySize, LDS_BYTES) != hipSuccess) { fprintf(stderr, "kernel_launch: hipFuncSetAttribute failed\n"); grid = -1; return; }
        if (hipOccupancyMaxActiveBlocksPerMultiprocessor(&per_cu, (const void*)mega, 512, LDS_BYTES) != hipSuccess || per_cu < 1) { fprintf(stderr, "kernel_launch: occupancy query gives %d\n", per_cu); per_cu = 1; }
        (void)hipGetLastError();
        grid = cus * per_cu;
    }
    if (grid < 0) return;
    Args a{};
    for (int i = 0; i < 29; ++i) a.in[i] = (const float*)d_in[i];
    a.out = (float*)d_out; a.ws = (unsigned char*)d_ws;
#if MK_MULTI
    for (int ph = 0; ph < NPHASE; ++ph) { a.ph_lo = ph; a.ph_hi = ph + 1; hipLaunchKernelGGL(mega, dim3(grid), dim3(512), LDS_BYTES, stream, a); }
#else
    a.ph_lo = 0; a.ph_hi = NPHASE;
    if (hipMemsetAsync(d_ws, 0, 16384, stream) != hipSuccess) { fprintf(stderr, "kernel_launch: hipMemsetAsync failed\n"); return; }
    void* args[] = {&a};
    const hipError_t e = hipLaunchCooperativeKernel((const void*)mega, dim3(grid), dim3(512), args, LDS_BYTES, stream);
    if (e != hipSuccess) fprintf(stderr, "kernel_launch: cooperative launch failed: %s (grid %d)\n", hipGetErrorString(e), grid);
#endif
}
```

```cpp
#include <hip/hip_runtime.h>
#include <hip/hip_cooperative_groups.h>
#include <cstdio>
#include <cstdint>
namespace cg = cooperative_groups;

namespace pg8 {
#define PG8_LAS __attribute__((address_space(3)))
typedef unsigned short bf16_t;
typedef short bf16x8 __attribute__((ext_vector_type(8)));
typedef float f32x4 __attribute__((ext_vector_type(4)));
typedef unsigned u32x4 __attribute__((ext_vector_type(4)));
constexpr int BM = 256, BK = 64, HALF = 128, HTB = HALF * BK * 2, STAGE_BYTES = 8 * HTB, NXCD = 8, WGM = 8;
__host__ __device__ __forceinline__ int lds_byte(int r, int c) { const int st = (r >> 4) * 2 + (c >> 5), rr = r & 15, cc = c & 31, ob = rr * 64 + cc * 2; return st * 1024 + (ob ^ (((ob >> 9) & 1) << 5)); }
__host__ __device__ __forceinline__ void stage_rc(int b, int& R, int& C) { const int st = b / 1024, sb = b % 1024, swz = sb ^ (((sb >> 9) & 1) << 5); R = (st >> 1) * 16 + swz / 64; C = (st & 1) * 32 + (swz % 64) / 2; }
__host__ __device__ __forceinline__ int perm32(int rho) { const int n = rho >> 4, i = rho & 15; return 8 * (i >> 2) + 4 * n + (i & 3); }

struct Unit { int pm, pn; int aoff; };
struct Gemm { const bf16_t* A; const bf16_t* Bt; int M, N, K; int lda; int cmp; int ldb; };

struct Order {
    int nM, nN, nwg, G, c, mode; int a1off, a2off, ksa, ksb;
    __device__ void init(int M, int N, int G_, int c_, int mode_) { nM = M / BM; nN = N / BM; nwg = nM * nN; G = G_; c = c_; mode = mode_; a1off = 0; a2off = 0; ksa = 0; ksb = 0; }
    __device__ bool next(int i, Unit& u) const {
        if (mode == 1) { const int tile = c + (i / 3) * G; if (tile >= nM * 8) return false; const int n = i % 3; int pm_ = tile >> 3, po_ = tile & 7;
            if (G == 256 && nM == 32) { const int x_ = c & 7, q_ = c >> 3; pm_ = 4 * x_ + (q_ >> 3); po_ = q_ & 7; }
            u.pm = pm_; u.pn = n * 8 + po_; u.aoff = n * 2048; return true; }
        if (mode == 2) { const long L = (long)i * G + c; if (L >= nM * 2) return false; u.pm = (int)(L >> 1); u.pn = (int)(L & 1); u.aoff = (L & 1) ? a2off : a1off; return true; }
        const long L = (long)i * G + c; if (L >= nwg) return false;
        int wgid = (int)L; { const int q = nwg / NXCD, r = nwg % NXCD, xcd = wgid % NXCD, off = wgid / NXCD; wgid = (xcd < r ? xcd * (q + 1) : r * (q + 1) + (xcd - r) * q) + off; }
        const int nig = WGM * nN, gid = wgid / nig, fm = gid * WGM, gsz = (nM - fm) < WGM ? (nM - fm) : WGM;
        u.pm = fm + ((wgid % nig) % gsz); u.pn = (wgid % nig) / gsz; u.aoff = 0; return true;
    }
    __device__ __forceinline__ void a_ready(const Unit&) const {}
    __device__ __forceinline__ void done(const Unit&) const {}
};
__device__ __forceinline__ unsigned cvt_pk_bf16(float lo, float hi) { unsigned r; asm volatile("v_cvt_pk_bf16_f32 %0, %1, %2" : "=v"(r) : "v"(lo), "v"(hi)); return r; }
__device__ __forceinline__ float sigm(float x) { return __builtin_amdgcn_rcpf(1.0f + __builtin_amdgcn_exp2f(-1.4426950408889634f * x)); }
__device__ __forceinline__ float bflo(unsigned w) { return __uint_as_float(w << 16); }
__device__ __forceinline__ float bfhi(unsigned w) { return __uint_as_float(w & 0xffff0000u); }


struct EpiSwiGLU {
    static constexpr bool PERM = true, AFTER_DRAIN = false; bf16_t* O; int ldc;
    __device__ __forceinline__ void operator()(const f32x4 (&acc)[2][2][4][2], const Unit& u, int wr, int wc, int fr, int fq) const {
        const int row0 = u.pm * BM + wr * 64 + fr, col0 = u.pn * HALF + wc * 32 + 8 * fq;
#pragma unroll
        for (int ai = 0; ai < 2; ++ai)
#pragma unroll
            for (int m = 0; m < 4; ++m) { bf16_t* rowp = O + (size_t)(row0 + ai * HALF + m * 16) * ldc + col0;
                f32x4 v[2];
#pragma unroll
                for (int n = 0; n < 2; ++n) { const f32x4 gt = acc[ai][0][m][n], up = acc[ai][1][m][n];
#pragma unroll
                    for (int e = 0; e < 4; ++e) v[n][e] = gt[e] * sigm(gt[e]) * up[e]; }
                u32x4 w; w.x = cvt_pk_bf16(v[0][0], v[0][1]); w.y = cvt_pk_bf16(v[0][2], v[0][3]); w.z = cvt_pk_bf16(v[1][0], v[1][1]); w.w = cvt_pk_bf16(v[1][2], v[1][3]);
                *(u32x4*)rowp = w; }
    }
};
struct EpiResid {
    static constexpr bool PERM = false, AFTER_DRAIN = false; const float* base; float* out; int ldc; float scale;
    __device__ __forceinline__ void operator()(const f32x4 (&acc)[2][2][4][2], const Unit& u, int wr, int wc, int fr, int fq) const {
        const int col0 = u.pn * BM + wc * 32 + 4 * fq;
        const size_t off0 = (size_t)(u.pm * BM + wr * 64 + fr) * ldc + col0;
        f32x4 cur[2][2], nxt[2][2];
#pragma unroll
        for (int bj = 0; bj < 2; ++bj)
#pragma unroll
            for (int n = 0; n < 2; ++n) cur[bj][n] = *(const f32x4*)(base + off0 + bj * HALF + n * 16);
#pragma unroll
        for (int gi = 0; gi < 8; ++gi) { const int ai = gi >> 2, m = gi & 3; const size_t off = off0 + (size_t)(ai * HALF + m * 16) * ldc;
            if (gi + 1 < 8) { const size_t offn = off0 + (size_t)(((gi + 1) >> 2) * HALF + ((gi + 1) & 3) * 16) * ldc;
#pragma unroll
                for (int bj = 0; bj < 2; ++bj)
#pragma unroll
                    for (int n = 0; n < 2; ++n) nxt[bj][n] = *(const f32x4*)(base + offn + bj * HALF + n * 16); }
#pragma unroll
            for (int bj = 0; bj < 2; ++bj)
#pragma unroll
                for (int n = 0; n < 2; ++n) { *(f32x4*)(out + off + bj * HALF + n * 16) = cur[bj][n] + acc[ai][bj][m][n] * scale; cur[bj][n] = nxt[bj][n]; }
            asm volatile("" ::: "memory"); }
    }
};
struct EpiStore {
    static constexpr bool PERM = true, AFTER_DRAIN = false; bf16_t* O0; int ld0; int npn0; bf16_t* O1; int ld1;
    __device__ __forceinline__ void operator()(const f32x4 (&acc)[2][2][4][2], const Unit& u, int wr, int wc, int fr, int fq) const {
        const bool sg = u.pn >= npn0; bf16_t* O = sg ? O1 : O0; const int ldc = sg ? ld1 : ld0; const int colt = (sg ? u.pn - npn0 : u.pn) * BM + wc * 32 + 8 * fq;
        const int row0 = u.pm * BM + wr * 64 + fr;
#pragma unroll
        for (int ai = 0; ai < 2; ++ai)
#pragma unroll
            for (int m = 0; m < 4; ++m) { bf16_t* rowp = O + (size_t)(row0 + ai * HALF + m * 16) * ldc + colt;
#pragma unroll
                for (int bj = 0; bj < 2; ++bj) { f32x4 v0 = acc[ai][bj][m][0], v1 = acc[ai][bj][m][1];
                    if (sg) {
#pragma unroll
                        for (int e = 0; e < 4; ++e) { v0[e] = sigm(v0[e]); v1[e] = sigm(v1[e]); } }
                    u32x4 w; w.x = cvt_pk_bf16(v0[0], v0[1]); w.y = cvt_pk_bf16(v0[2], v0[3]); w.z = cvt_pk_bf16(v1[0], v1[1]); w.w = cvt_pk_bf16(v1[2], v1[3]);
                    *(u32x4*)(rowp + bj * HALF) = w; } }
    }
};
struct EpiCmp {
    static constexpr bool PERM = true, AFTER_DRAIN = false; bf16_t* hid; const float* bias; int nvalid;
    __device__ __forceinline__ void operator()(const f32x4 (&acc)[2][2][4][2], const Unit& u, int wr, int wc, int fr, int fq) const {
        bf16_t* O = hid + (size_t)u.pn * 2048 * 256; const float* bb = bias + u.pn * 256;
        const int row0 = u.pm * BM + wr * 64 + fr, col0 = wc * 32 + 8 * fq;
#pragma unroll
        for (int ai = 0; ai < 2; ++ai)
#pragma unroll
            for (int m = 0; m < 4; ++m) { const int row = row0 + ai * HALF + m * 16;
#pragma unroll
                for (int bj = 0; bj < 2; ++bj) { const f32x4 b0 = *(const f32x4*)(bb + col0 + bj * HALF), b1 = *(const f32x4*)(bb + col0 + bj * HALF + 4);
                    f32x4 v0 = acc[ai][bj][m][0] + b0, v1 = acc[ai][bj][m][1] + b1;
#pragma unroll
                    for (int e = 0; e < 4; ++e) { v0[e] = v0[e] * sigm(v0[e]); v1[e] = v1[e] * sigm(v1[e]); }
                    u32x4 w; w.x = cvt_pk_bf16(v0[0], v0[1]); w.y = cvt_pk_bf16(v0[2], v0[3]); w.z = cvt_pk_bf16(v1[0], v1[1]); w.w = cvt_pk_bf16(v1[2], v1[3]);
                    if (row < nvalid) *(u32x4*)(O + (size_t)row * 256 + col0 + bj * HALF) = w; } }
    }
};
struct EpiMerge {
    static constexpr bool PERM = true, AFTER_DRAIN = false; const bf16_t* gate; int ldg; float* mf; bf16_t* merged;
    __device__ __forceinline__ void operator()(const f32x4 (&acc)[2][2][4][2], const Unit& u, int wr, int wc, int fr, int fq) const {
        const int nbr = u.pn >> 3, pno = u.pn & 7;
        const int row0 = u.pm * BM + wr * 64 + fr, gcol = u.pn * BM + wc * 32 + 8 * fq, ocol = pno * BM + wc * 32 + 8 * fq;
        u32x4 gcur[2], gnxt[2]; f32x4 mcur[2][2], mnxt[2][2];
#pragma unroll
        for (int bj = 0; bj < 2; ++bj) { gcur[bj] = *(const u32x4*)(gate + (size_t)row0 * ldg + gcol + bj * HALF);
            if (nbr > 0) { const float* mp = mf + (size_t)row0 * 2048 + ocol + bj * HALF; mcur[bj][0] = *(const f32x4*)mp; mcur[bj][1] = *(const f32x4*)(mp + 4); } }
#pragma unroll
        for (int gi = 0; gi < 8; ++gi) { const int ai = gi >> 2, m = gi & 3; const int row = row0 + ai * HALF + m * 16;
            if (gi + 1 < 8) { const int rown = row0 + ((gi + 1) >> 2) * HALF + ((gi + 1) & 3) * 16;
#pragma unroll
                for (int bj = 0; bj < 2; ++bj) { gnxt[bj] = *(const u32x4*)(gate + (size_t)rown * ldg + gcol + bj * HALF);
                    if (nbr > 0) { const float* mp = mf + (size_t)rown * 2048 + ocol + bj * HALF; mnxt[bj][0] = *(const f32x4*)mp; mnxt[bj][1] = *(const f32x4*)(mp + 4); } } }
#pragma unroll
            for (int bj = 0; bj < 2; ++bj) { const u32x4 gw = gcur[bj];
                f32x4 v0 = acc[ai][bj][m][0], v1 = acc[ai][bj][m][1];
                v0[0] *= bflo(gw.x); v0[1] *= bfhi(gw.x); v0[2] *= bflo(gw.y); v0[3] *= bfhi(gw.y); v1[0] *= bflo(gw.z); v1[1] *= bfhi(gw.z); v1[2] *= bflo(gw.w); v1[3] *= bfhi(gw.w);
                float* mp = mf + (size_t)row * 2048 + ocol + bj * HALF;
                if (nbr > 0) { v0 += mcur[bj][0]; v1 += mcur[bj][1]; }
                if (nbr < 2) { *(f32x4*)mp = v0; *(f32x4*)(mp + 4) = v1; }
                else { u32x4 w; w.x = cvt_pk_bf16(v0[0], v0[1]); w.y = cvt_pk_bf16(v0[2], v0[3]); w.z = cvt_pk_bf16(v1[0], v1[1]); w.w = cvt_pk_bf16(v1[2], v1[3]);
                    *(u32x4*)(merged + (size_t)row * 2048 + ocol + bj * HALF) = w; }
                gcur[bj] = gnxt[bj]; mcur[bj][0] = mnxt[bj][0]; mcur[bj][1] = mnxt[bj][1]; }
            asm volatile("" ::: "memory"); }
    }
};

template <class Epi, class Sched, bool ALIGN_EPI = false, bool SP2 = false>
__device__ __forceinline__ void gemm_phase(PG8_LAS unsigned char* lds, const Gemm g, const Sched& S, const Epi& E, int wave_id) {
    unsigned lm_ = ~0u; asm volatile("" : "+s"(lm_)); int tid_ = (wave_id << 6) | (int)__builtin_amdgcn_mbcnt_hi(lm_, __builtin_amdgcn_mbcnt_lo(lm_, 0u));     const int tid = tid_, wid = __builtin_amdgcn_readfirstlane(tid >> 6), lane = tid & 63, wr = wid >> 2, wc = wid & 3, fr = lane & 15, fq = lane >> 4;
    const int K = g.K, nt = K / BK;
    unsigned voffA[2], voffB[2];
#pragma unroll
    for (int i = 0; i < 2; ++i) { int R, C; stage_rc(tid * 16 + i * 8192, R, C); const int Rb = Epi::PERM ? ((R & ~31) + perm32(R & 31)) : R;
        voffA[i] = g.cmp ? (unsigned)(((R >> 2) * 16 * g.lda + (R & 3) * 64 + C) * 2) : (unsigned)(R * g.lda + C) * 2u; voffB[i] = (unsigned)(Rb * g.ldb + C) * 2u; }
    const size_t kstep = (size_t)(BK * 2);
    const size_t hstep = (size_t)HALF * g.ldb * 2;
    const size_t tstep = 2 * hstep; const size_t kstepA = g.cmp ? (size_t)g.lda * 2 : (size_t)(BK * 2); const size_t hstepA = g.cmp ? (size_t)32 * 16 * g.lda * 2 : (size_t)HALF * g.lda * 2; const size_t tstepA = 2 * hstepA;
    const unsigned ldsw = (unsigned)wid * 1024u;
    const int aoff = lds_byte(wr * 64 + fr, fq * 8), boff = lds_byte(wc * 32 + fr, fq * 8);
#define PG8_SA(b, h) (((b) * 2 + (h)) * HTB)
#define PG8_SB(b, h) ((4 + (b) * 2 + (h)) * HTB)
#define PG8_STAGE(bufoff, gbase, voff) do { _Pragma("unroll") for (int _i = 0; _i < 2; ++_i) \
        __builtin_amdgcn_global_load_lds((const unsigned*)((const char*)(gbase) + (voff)[_i]), (PG8_LAS unsigned*)(lds + (bufoff) + ldsw + _i * 8192), 16, 0, 0); } while (0)
#define PG8_LDA(dst, b, h) do { _Pragma("unroll") for (int m = 0; m < 4; ++m) _Pragma("unroll") for (int k = 0; k < 2; ++k) dst[m][k] = *(const PG8_LAS bf16x8*)(lds + PG8_SA(b, h) + aoff + m * 2048 + k * 1024); } while (0)
#define PG8_LDB(dst, b, h) do { _Pragma("unroll") for (int n = 0; n < 2; ++n) _Pragma("unroll") for (int k = 0; k < 2; ++k) dst[n][k] = *(const PG8_LAS bf16x8*)(lds + PG8_SB(b, h) + boff + n * 2048 + k * 1024); } while (0)
#define PG8_MMA(ai, bj, At, Bt) do { __builtin_amdgcn_s_setprio(1); _Pragma("unroll") for (int m = 0; m < 4; ++m) _Pragma("unroll") for (int n = 0; n < 2; ++n) _Pragma("unroll") for (int k = 0; k < 2; ++k) \
        acc[ai][bj][m][n] = __builtin_amdgcn_mfma_f32_16x16x32_bf16(Bt[n][k], At[m][k], acc[ai][bj][m][n], 0, 0, 0); __builtin_amdgcn_s_setprio(0); } while (0)
#define PG8_WAIT_V(n) asm volatile("s_waitcnt vmcnt(" #n ")" ::: "memory")
#define PG8_WAIT_L(n) asm volatile("s_waitcnt lgkmcnt(" #n ")" ::: "memory")
#define PG8_BAR __builtin_amdgcn_s_barrier()
#define PG8_SCHED __builtin_amdgcn_sched_barrier(0)
    Unit cur, nxt; int ui = 0;
    if (!S.next(0, cur)) return;
    f32x4 acc[2][2][4][2];
    { f32x4 zq_ = {0.f, 0.f, 0.f, 0.f}; asm volatile("" : "+v"(zq_));
#pragma unroll
    for (int a = 0; a < 2; ++a)
#pragma unroll
        for (int b = 0; b < 2; ++b)
#pragma unroll
            for (int m = 0; m < 4; ++m)
#pragma unroll
                for (int n = 0; n < 2; ++n) acc[a][b][m][n] = zq_; }
    bf16x8 At[4][2], B0[2][2], B1[2][2];
    const char* cA = (const char*)g.A + (size_t)cur.pm * tstepA + cur.aoff; const char* cB = (const char*)g.Bt + (size_t)(cur.pn & 255) * tstep + (size_t)(cur.pn >> 8) * 512;
    S.a_ready(cur);
    if constexpr (SP2) {
        PG8_STAGE(PG8_SB(0, 0), cB, voffB); PG8_STAGE(PG8_SB(0, 1), cB + hstep, voffB); PG8_STAGE(PG8_SA(0, 0), cA, voffA); PG8_STAGE(PG8_SA(0, 1), cA + hstepA, voffA);
        if (wr == 1) PG8_BAR;
        PG8_WAIT_V(2); PG8_BAR;
        PG8_STAGE(PG8_SB(1, 0), cB + kstep, voffB); PG8_STAGE(PG8_SA(1, 0), cA + kstepA, voffA); PG8_STAGE(PG8_SB(1, 1), cB + hstep + kstep, voffB);
        PG8_WAIT_V(6); PG8_BAR;
    } else {
        PG8_STAGE(PG8_SB(0, 0), cB, voffB); PG8_STAGE(PG8_SA(0, 0), cA, voffA); PG8_STAGE(PG8_SB(0, 1), cB + hstep, voffB); PG8_STAGE(PG8_SA(0, 1), cA + hstepA, voffA);
        if (wr == 1) PG8_BAR;
        PG8_WAIT_V(4); PG8_BAR;
        PG8_STAGE(PG8_SB(1, 0), cB + kstep, voffB); PG8_STAGE(PG8_SA(1, 0), cA + kstepA, voffA); PG8_STAGE(PG8_SB(1, 1), cB + hstep + kstep, voffB);
        PG8_WAIT_V(6); PG8_BAR;
    }
    for (;;) {
        const bool has_next = S.next(ui + 1, nxt);
        const char* nA = has_next ? (const char*)g.A + (size_t)nxt.pm * tstepA + nxt.aoff : cA; const char* nB = has_next ? (const char*)g.Bt + (size_t)(nxt.pn & 255) * tstep + (size_t)(nxt.pn >> 8) * 512 : cB;
        for (int t = 0; t < nt; t += 2) {
            const bool last = (t == nt - 2);
            const char* a1 = cA + (size_t)(t + 1) * kstepA;
            const char* a2 = last ? nA : cA + (size_t)(t + 2) * kstepA; const char* b2 = last ? nB : cB + (size_t)(t + 2) * kstep;
            const char* a3 = a2 + kstepA; const char* b3 = b2 + kstep;
            if (last && has_next) S.a_ready(nxt);
            if constexpr (SP2) {
            PG8_LDB(B0, 0, 0); PG8_LDB(B1, 0, 1); PG8_SCHED; PG8_LDA(At, 0, 0); PG8_STAGE(PG8_SA(1, 1), a1 + hstepA, voffA);
            PG8_WAIT_V(8); PG8_WAIT_L(0); PG8_BAR; PG8_MMA(0, 0, At, B0); PG8_MMA(0, 1, At, B1); PG8_BAR; PG8_SCHED;
            PG8_LDA(At, 0, 1); PG8_STAGE(PG8_SB(0, 0), b2, voffB); PG8_STAGE(PG8_SB(0, 1), b2 + hstep, voffB); PG8_STAGE(PG8_SA(0, 0), a2, voffA);
            PG8_WAIT_V(8); PG8_WAIT_L(0); PG8_BAR; PG8_MMA(1, 0, At, B0); PG8_MMA(1, 1, At, B1); PG8_BAR; PG8_SCHED;
            PG8_LDB(B0, 1, 0); PG8_LDB(B1, 1, 1); PG8_SCHED; PG8_LDA(At, 1, 0); PG8_STAGE(PG8_SA(0, 1), a2 + hstepA, voffA);
            PG8_WAIT_V(8); PG8_WAIT_L(0); PG8_BAR; PG8_MMA(0, 0, At, B0); PG8_MMA(0, 1, At, B1); PG8_BAR; PG8_SCHED;
            PG8_LDA(At, 1, 1); PG8_STAGE(PG8_SB(1, 0), b3, voffB); PG8_STAGE(PG8_SB(1, 1), b3 + hstep, voffB); PG8_STAGE(PG8_SA(1, 0), a3, voffA);
            PG8_WAIT_V(8); PG8_WAIT_L(0); PG8_BAR; PG8_MMA(1, 0, At, B0); PG8_MMA(1, 1, At, B1); PG8_BAR; PG8_SCHED;
            } else {
            PG8_LDB(B0, 0, 0); PG8_SCHED; PG8_LDA(At, 0, 0); PG8_STAGE(PG8_SA(1, 1), a1 + hstepA, voffA);
            PG8_WAIT_L(8); PG8_BAR; PG8_WAIT_L(0); PG8_MMA(0, 0, At, B0); PG8_BAR; PG8_SCHED;
            PG8_LDB(B1, 0, 1); PG8_STAGE(PG8_SB(0, 0), b2, voffB);
            PG8_BAR; PG8_WAIT_L(0); PG8_MMA(0, 1, At, B1); PG8_BAR;
            PG8_LDA(At, 0, 1); PG8_STAGE(PG8_SA(0, 0), a2, voffA);
            PG8_BAR; PG8_WAIT_L(0); PG8_MMA(1, 0, At, B0); PG8_BAR; PG8_SCHED;
            PG8_STAGE(PG8_SB(0, 1), b2 + hstep, voffB);
            PG8_WAIT_V(6); PG8_BAR; PG8_MMA(1, 1, At, B1); PG8_BAR;
            PG8_LDB(B0, 1, 0); PG8_SCHED; PG8_LDA(At, 1, 0); PG8_STAGE(PG8_SA(0, 1), a2 + hstepA, voffA);
            PG8_WAIT_L(8); PG8_BAR; PG8_WAIT_L(0); PG8_MMA(0, 0, At, B0); PG8_BAR; PG8_SCHED;
            PG8_LDB(B1, 1, 1); PG8_STAGE(PG8_SB(1, 0), b3, voffB);
            PG8_BAR; PG8_WAIT_L(0); PG8_MMA(0, 1, At, B1); PG8_BAR;
            PG8_LDA(At, 1, 1); PG8_STAGE(PG8_SA(1, 0), a3, voffA);
            PG8_BAR; PG8_WAIT_L(0); PG8_MMA(1, 0, At, B0); PG8_BAR; PG8_SCHED;
            PG8_STAGE(PG8_SB(1, 1), b3 + hstep, voffB);
            PG8_WAIT_V(6); PG8_BAR; PG8_MMA(1, 1, At, B1); PG8_BAR;
            }
        }
        if constexpr (ALIGN_EPI) { if (wr == 0) PG8_BAR; }
        if constexpr (!Epi::AFTER_DRAIN) { E(acc, cur, wr, wc, fr, fq); S.done(cur); }
        if (!has_next) break;
        { f32x4 zq_ = {0.f, 0.f, 0.f, 0.f}; asm volatile("" : "+v"(zq_));
#pragma unroll
        for (int a = 0; a < 2; ++a)
#pragma unroll
            for (int b = 0; b < 2; ++b)
#pragma unroll
                for (int m = 0; m < 4; ++m)
#pragma unroll
                    for (int n = 0; n < 2; ++n) acc[a][b][m][n] = zq_; }
        cur = nxt; cA = nA; cB = nB; ++ui;
        if constexpr (ALIGN_EPI) { if (wr == 1) PG8_BAR; }
    }
    PG8_WAIT_V(0);
    if constexpr (!ALIGN_EPI) { if (wr == 0) PG8_BAR; }
    PG8_BAR;
    if constexpr (Epi::AFTER_DRAIN) { E.fused(acc, cur, wr, wc, fr, fq, lds, wid, lane); S.done(cur); }
#undef PG8_SA
#undef PG8_SB
#undef PG8_STAGE
#undef PG8_LDA
#undef PG8_LDB
#undef PG8_MMA
#undef PG8_WAIT_V
#undef PG8_WAIT_L
#undef PG8_BAR
#undef PG8_SCHED
}
}

#define LAS __attribute__((address_space(3)))
typedef unsigned short bf16_t;
typedef short bf16x8 __attribute__((ext_vector_type(8)));
typedef float f32x4 __attribute__((ext_vector_type(4)));
typedef unsigned u32x4 __attribute__((ext_vector_type(4)));
typedef unsigned u32x2 __attribute__((ext_vector_type(2)));
using pg8::cvt_pk_bf16; using pg8::sigm; using pg8::bflo; using pg8::bfhi;

constexpr int DM = 2048, SEQ = 8192, MTOK = 16384, DFF = 5632;
constexpr int ZM = 6912, ZG = 6144, NZ0 = 27;
constexpr int ZC_B = 0, ZC_Q = 1024, ZC_QM = 2048, ZC_C = 3072, ZC_U = 4096, ZC_KC = 5120, ZC_VC = 5376, ZC_KS = 5632, ZC_VS = 5888, ZC_KW = 6144, ZC_VW = 6400, ZC_G = 6656;
constexpr float EPS = 1e-6f, LOG2E = 1.4426950408889634f;
constexpr size_t MiB = 1u << 20;
constexpr size_t WS_WIN = 1 * MiB, WS_WMK = 52 * MiB, WS_WBR = 60 * MiB, WS_WO = 72 * MiB, WS_WC1 = 80 * MiB, WS_BIASC = 82 * MiB, WS_MEMN = 83 * MiB, WS_KVM = 85 * MiB, WS_VMT = 87 * MiB;
constexpr size_t WS_WGU2 = 88 * MiB, WS_WD2 = 132 * MiB, WS_H = 154 * MiB, WS_MF = 218 * MiB, WS_WGU1 = 282 * MiB, WS_WD1 = 326 * MiB, WS_ACT = 348 * MiB, WS_END = 524 * MiB;
constexpr size_t WS_ZMAIN = 282 * MiB, WS_ZGATE = 390 * MiB, WS_VST = 486 * MiB, WS_VWT = 490 * MiB, WS_HID = 494 * MiB, WS_KC = 496 * MiB, WS_VCT = 497 * MiB;
constexpr int LDS_BYTES = 147456;
constexpr int NPHASE = 19;

#define LDS_WAIT() asm volatile("s_waitcnt lgkmcnt(0)" ::: "memory")
__device__ __forceinline__ float bf2f(bf16_t v) { return __uint_as_float((unsigned)v << 16); }
__device__ __forceinline__ void unpack8(const u32x4 w, float (&f)[8]) { f[0] = bflo(w.x); f[1] = bfhi(w.x); f[2] = bflo(w.y); f[3] = bfhi(w.y); f[4] = bflo(w.z); f[5] = bfhi(w.z); f[6] = bflo(w.w); f[7] = bfhi(w.w); }
__device__ __forceinline__ u32x4 pack8(const float (&f)[8]) { u32x4 w; w.x = cvt_pk_bf16(f[0], f[1]); w.y = cvt_pk_bf16(f[2], f[3]); w.z = cvt_pk_bf16(f[4], f[5]); w.w = cvt_pk_bf16(f[6], f[7]); return w; }
__device__ __forceinline__ f32x4 mfma16(bf16x8 a, bf16x8 b, f32x4 c) { return __builtin_amdgcn_mfma_f32_16x16x32_bf16(a, b, c, 0, 0, 0); }
__device__ __forceinline__ float x16max(float x) { auto r = __builtin_amdgcn_permlane16_swap(__float_as_uint(x), __float_as_uint(x), false, false); return fmaxf(__uint_as_float(r[0]), __uint_as_float(r[1])); }
__device__ __forceinline__ float x32max(float x) { auto r = __builtin_amdgcn_permlane32_swap(__float_as_uint(x), __float_as_uint(x), false, false); return fmaxf(__uint_as_float(r[0]), __uint_as_float(r[1])); }
__device__ __forceinline__ float x16sum(float x) { auto r = __builtin_amdgcn_permlane16_swap(__float_as_uint(x), __float_as_uint(x), false, false); return __uint_as_float(r[0]) + __uint_as_float(r[1]); }
__device__ __forceinline__ float x32sum(float x) { auto r = __builtin_amdgcn_permlane32_swap(__float_as_uint(x), __float_as_uint(x), false, false); return __uint_as_float(r[0]) + __uint_as_float(r[1]); }
__device__ __forceinline__ float quadsum(float x) {
    x += __int_as_float(__builtin_amdgcn_update_dpp(0, __float_as_int(x), 0xB1, 0xF, 0xF, true));
    x += __int_as_float(__builtin_amdgcn_update_dpp(0, __float_as_int(x), 0x4E, 0xF, 0xF, true));
    return x; }

#define DPPF(x, ctrl) __int_as_float(__builtin_amdgcn_update_dpp(0, __float_as_int(x), (ctrl), 0xF, 0xF, true))
__device__ __forceinline__ float sum8(float x) { x += DPPF(x, 0xB1); x += DPPF(x, 0x4E); x += DPPF(x, 0x141); return x; }
__device__ __forceinline__ float sum16(float x) { x = sum8(x); x += DPPF(x, 0x140); return x; }
__device__ __forceinline__ float sum32(float x) { return x16sum(sum16(x)); }
__device__ __forceinline__ float wave_sum(float x) { return x32sum(x16sum(sum16(x))); }

__device__ __forceinline__ void tr_item(const float* W, int ldw, int col0, int ncols, int K, bf16_t* WT, int row0, int mode, LAS float* scr, int item, int lane) {
    const int nblk = (ncols + 31) >> 5, kb = item / nblk, nb = item - kb * nblk, k0 = 64 * kb, n0 = 32 * nb;
    const int nn = n0 + 4 * (lane & 7); const bool ok = nn < ncols;
    const f32x4 z4f = {0.f, 0.f, 0.f, 0.f};
#pragma unroll
    for (int i = 0; i < 8; ++i) { const int kk = 8 * i + (lane >> 3); const f32x4 v = ok ? *(const f32x4*)(W + (size_t)(k0 + kk) * ldw + col0 + nn) : z4f;
        LAS float* d = scr + kk * 33 + 4 * (lane & 7); d[0] = v.x; d[1] = v.y; d[2] = v.z; d[3] = v.w; }
    LDS_WAIT();
    const int cc = lane & 7;
#pragma unroll
    for (int j = 0; j < 4; ++j) { const int nl = (lane >> 3) + 8 * j, n = n0 + nl; const LAS float* s = scr + (8 * cc) * 33 + nl;
        u32x4 o; o.x = cvt_pk_bf16(s[0 * 33], s[1 * 33]); o.y = cvt_pk_bf16(s[2 * 33], s[3 * 33]); o.z = cvt_pk_bf16(s[4 * 33], s[5 * 33]); o.w = cvt_pk_bf16(s[6 * 33], s[7 * 33]);
        if (n < ncols) { const int drow = mode ? row0 + (n >> 7) * 256 + (n & 127) : row0 + n; *(u32x4*)(WT + (size_t)drow * K + k0 + 8 * cc) = o; } }
    LDS_WAIT();
}
__device__ __forceinline__ void rms_row(const float* xr, const float* gain, bf16_t* o, int lane) {
    const f32x4* x4 = (const f32x4*)xr + lane; const f32x4* g4 = (const f32x4*)gain + lane;
    f32x4 v[8]; float s = 0.f;
#pragma unroll
    for (int j = 0; j < 8; ++j) { v[j] = x4[64 * j]; s += (v[j].x * v[j].x + v[j].y * v[j].y) + (v[j].z * v[j].z + v[j].w * v[j].w); }
    const float r = 1.0f / sqrtf(wave_sum(s) * (1.0f / 2048.0f) + EPS);
    u32x2* o2 = (u32x2*)o + lane;
#pragma unroll
    for (int j = 0; j < 8; ++j) { const f32x4 gg = g4[64 * j]; u32x2 w; w.x = cvt_pk_bf16(v[j].x * r * gg.x, v[j].y * r * gg.y); w.y = cvt_pk_bf16(v[j].z * r * gg.z, v[j].w * r * gg.w); o2[64 * j] = w; }
}

__device__ __forceinline__ void tok_prep(bf16_t* zb, int t, const float* conv_w, const float* gq, const float* gks, const float* gkw, const float* gmq, int lane, bool do_store = true) {
    bf16_t* zr = zb + (size_t)t * ZM;
    const u32x4 z4 = {0u, 0u, 0u, 0u};
#pragma unroll
    for (int it = 0; it < 2; ++it) {
        const int col = it * 512 + lane * 8;
        const u32x4 bb = *(const u32x4*)(zr + ZC_B + col), c0 = *(const u32x4*)(zr + ZC_C + col), u0 = *(const u32x4*)(zr + ZC_U + col);
        u32x4 c1 = z4, u1 = z4, c2 = z4, u2 = z4;
        if (t >= 1) { c1 = *(const u32x4*)(zr - ZM + ZC_C + col); u1 = *(const u32x4*)(zr - ZM + ZC_U + col); }
        if (t >= 2) { c2 = *(const u32x4*)(zr - 2 * ZM + ZC_C + col); u2 = *(const u32x4*)(zr - 2 * ZM + ZC_U + col); }
        float fb[8], fc0[8], fu0[8], fc1[8], fu1[8], fc2[8], fu2[8], y[8];
        unpack8(bb, fb); unpack8(c0, fc0); unpack8(u0, fu0); unpack8(c1, fc1); unpack8(u1, fu1); unpack8(c2, fc2); unpack8(u2, fu2);
#pragma unroll
        for (int e = 0; e < 8; ++e) { const float w0 = conv_w[col + e], w1 = conv_w[1024 + col + e], w2 = conv_w[2048 + col + e];
            y[e] = fb[e] * (w0 * (fc2[e] * fu2[e]) + w1 * (fc1[e] * fu1[e]) + w2 * (fc0[e] * fu0[e])); }
        if (do_store || y[0] == 12345.678f) *(u32x4*)(zr + ZC_B + col) = pack8(y);
    }
#pragma unroll
    for (int it = 0; it < 2; ++it) {
        const int col = it * 512 + lane * 8; float q[8], y[8]; unpack8(*(const u32x4*)(zr + ZC_Q + col), q);
        float ss = 0.f;
#pragma unroll
        for (int e = 0; e < 8; ++e) ss += q[e] * q[e];
        ss = sum8(ss);
        const float r = (1.0f / sqrtf(ss * (1.0f / 64.0f) + EPS)) * (0.125f * LOG2E); const int d = col & 63;
#pragma unroll
        for (int e = 0; e < 8; ++e) y[e] = q[e] * r * gq[d + e];
        if (do_store || y[0] == 12345.678f) *(u32x4*)(zr + ZC_Q + col) = pack8(y);
    }
    {
        const int col = (lane < 32 ? ZC_KS : ZC_KW) + (lane & 31) * 8; const float* gk = lane < 32 ? gks : gkw;
        float q[8], y[8]; unpack8(*(const u32x4*)(zr + col), q);
        float ss = 0.f;
#pragma unroll
        for (int e = 0; e < 8; ++e) ss += q[e] * q[e];
        ss = sum8(ss);
        const float r = 1.0f / sqrtf(ss * (1.0f / 64.0f) + EPS); const int d = (lane * 8) & 63;
#pragma unroll
        for (int e = 0; e < 8; ++e) y[e] = q[e] * r * gk[d + e];
        if (do_store || y[0] == 12345.678f) *(u32x4*)(zr + col) = pack8(y);
    }
#pragma unroll
    for (int it = 0; it < 2; ++it) {
        const int col = it * 512 + lane * 8; float q[8], y[8]; unpack8(*(const u32x4*)(zr + ZC_QM + col), q);
        float ss = 0.f;
#pragma unroll
        for (int e = 0; e < 8; ++e) ss += q[e] * q[e];
        ss = sum32(ss);
        const float r = (1.0f / sqrtf(ss * (1.0f / 256.0f) + EPS)) * (0.0625f * LOG2E); const int d = col & 255;
#pragma unroll
        for (int e = 0; e < 8; ++e) y[e] = q[e] * r * gmq[d + e];
        if (do_store || y[0] == 12345.678f) *(u32x4*)(zr + ZC_QM + col) = pack8(y);
    }
}

#define NSA_TILE_SRC(I, KP, LDK, VP, LDV) do { if ((I) < 2 * nc) { const int kt_ = (I) < nc ? (I) : (I) - nc; KP = kcb + ((size_t)g * 512 + kt_ * 64) * 64; LDK = 64; VP = vctb + (size_t)g * 64 * 512 + kt_ * 64; LDV = 512; } \
    else if ((I) < 2 * nc + cur + 1) { const int s_ = (I) - 2 * nc; KP = zb + (size_t)(s_ * 64) * ZM + ZC_KS + g * 64; LDK = ZM; VP = vst + (size_t)g * 64 * SEQ + s_ * 64; LDV = SEQ; } \
    else { const int w_ = ws0 + (I) - (2 * nc + cur + 1); KP = zb + (size_t)(w_ * 64) * ZM + ZC_KW + g * 64; LDK = ZM; VP = vwt + (size_t)g * 64 * SEQ + w_ * 64; LDV = SEQ; } } while (0)

template <int MODE> __device__ __forceinline__ void tile_softmax(f32x4 (&S)[4], bool rowv, int kfirst, int klo, unsigned kspan, float& l) {
    float ps = 0.f;
#pragma unroll
    for (int st = 0; st < 4; ++st)
#pragma unroll
        for (int j = 0; j < 4; ++j) { float e = __builtin_amdgcn_exp2f(S[st][j]);
            if (MODE == 1) e = rowv ? e : 0.f;
            if (MODE == 2) e = ((unsigned)(kfirst + st * 16 + j - klo) <= kspan) ? e : 0.f;
            S[st][j] = e; ps += e; }
    l += ps;
}

__device__ __forceinline__ void nsa_loadk(const LAS unsigned char* kbuf, int offk0, int offk1, bf16x8 (&ka)[4], bf16x8 (&kb)[4]) {
#pragma unroll
    for (int st = 0; st < 4; ++st) { ka[st] = *(const LAS bf16x8*)(kbuf + offk0 + st * 2048); kb[st] = *(const LAS bf16x8*)(kbuf + offk1 + st * 2048); }
}
__device__ __forceinline__ void nsa_loadv(const LAS unsigned char* vbuf, int offv00, int offv01, int offv10, int offv11, u32x4 (&vf)[2][4]) {
#pragma unroll
    for (int dt = 0; dt < 4; ++dt) { const u32x2 lo0 = *(const LAS u32x2*)(vbuf + offv00 + dt * 2048), hi0 = *(const LAS u32x2*)(vbuf + offv01 + dt * 2048), lo1 = *(const LAS u32x2*)(vbuf + offv10 + dt * 2048), hi1 = *(const LAS u32x2*)(vbuf + offv11 + dt * 2048);
        vf[0][dt].x = lo0.x; vf[0][dt].y = lo0.y; vf[0][dt].z = hi0.x; vf[0][dt].w = hi0.y; vf[1][dt].x = lo1.x; vf[1][dt].y = lo1.y; vf[1][dt].z = hi1.x; vf[1][dt].w = hi1.y; }
}
__device__ __forceinline__ void nsa_scores(const bf16x8 (&ka)[4], const bf16x8 (&kb)[4], bf16x8 q0, bf16x8 q1, f32x4 (&S)[4]) {
    const f32x4 zero4 = {0.f, 0.f, 0.f, 0.f};
#pragma unroll
    for (int st = 0; st < 4; ++st) S[st] = mfma16(ka[st], q0, zero4);
#pragma unroll
    for (int st = 0; st < 4; ++st) S[st] = mfma16(kb[st], q1, S[st]);
}
__device__ __forceinline__ void nsa_pack(const f32x4 (&P)[4], u32x4 (&pf)[2]) {
#pragma unroll
    for (int hf = 0; hf < 2; ++hf) { pf[hf].x = cvt_pk_bf16(P[2 * hf][0], P[2 * hf][1]); pf[hf].y = cvt_pk_bf16(P[2 * hf][2], P[2 * hf][3]); pf[hf].z = cvt_pk_bf16(P[2 * hf + 1][0], P[2 * hf + 1][1]); pf[hf].w = cvt_pk_bf16(P[2 * hf + 1][2], P[2 * hf + 1][3]); }
}
__device__ __forceinline__ void nsa_pv(const u32x4 (&vf)[2][4], const u32x4 (&pf)[2], f32x4 (&O)[4]) {
#pragma unroll
    for (int hf = 0; hf < 2; ++hf)
#pragma unroll
        for (int dt = 0; dt < 4; ++dt) O[dt] = mfma16(__builtin_bit_cast(bf16x8, vf[hf][dt]), __builtin_bit_cast(bf16x8, pf[hf]), O[dt]);
}

__device__ __forceinline__ void nsa_wg_task(bf16_t* zb, const bf16_t* kcb, const bf16_t* vctb, const bf16_t* vst, const bf16_t* vwt, int g, int T0, float* accb, LAS unsigned char* lds, int wave, int lane, int tid) {
    const int n = lane & 15, fq = lane >> 4, ti = n >> 2, h = n & 3, Tmax = T0 + 63;
    f32x4 zero4 = {0.f, 0.f, 0.f, 0.f}; asm volatile("" : "+v"(zero4));
    float NEG = -1e30f, FORCE = 1e9f; asm volatile("" : "+v"(NEG), "+v"(FORCE));
    int t0[2], t[2], tmax[2], nv[2], nvl[2], nproc[2]; bf16x8 q0[2], q1[2]; float gate_c[2], gate_s[2], gate_w[2]; f32x4 O[2][4]; float l[2], il[2];
#pragma unroll
    for (int r = 0; r < 2; ++r) { t0[r] = T0 + wave * 8 + 4 * r; t[r] = t0[r] + ti; tmax[r] = t0[r] + 3;
        const bf16_t* zr = zb + (size_t)t[r] * ZM; const bf16_t* qp = zr + ZC_Q + (g * 4 + h) * 64 + 8 * fq; q0[r] = *(const bf16x8*)qp; q1[r] = *(const bf16x8*)(qp + 32);
        const bf16_t* gp = zr + ZC_G + (g * 4 + h) * 3; gate_c[r] = sigm(bf2f(gp[0])); gate_s[r] = sigm(bf2f(gp[1])); gate_w[r] = sigm(bf2f(gp[2]));
        nv[r] = tmax[r] >= 31 ? ((tmax[r] - 31) >> 4) + 1 : 0; nvl[r] = t[r] >= 31 ? ((t[r] - 31) >> 4) + 1 : 0; nproc[r] = ((nv[r] + 63) >> 6) * 64;
        l[r] = 0.f; il[r] = 0.f;
#pragma unroll
        for (int dt = 0; dt < 4; ++dt) O[r][dt] = zero4; }
    LAS unsigned* wM = (LAS unsigned*)(lds + 131072 + 1024 + wave * 128);
    LAS float* wA = (LAS float*)(lds + 98304 + wave * 4096);
    const int nc = ((((Tmax - 31) >> 4) + 1) + 63) >> 6;
    const int cur = T0 >> 6, ws0 = (T0 - 511 > 0 ? T0 - 511 : 0) >> 6, nw = cur - ws0 + 1, NT = 2 * nc + cur + 1 + nw;
    const int xk_ = ((lane & 15) >> 1) & 7, rb_ = (lane & 15) * 128, offk0 = rb_ + ((fq ^ xk_) << 4), offk1 = rb_ + (((4 + fq) ^ xk_) << 4);
    const int vb_ = rb_ + (fq & 1) * 8, cv_ = fq >> 1, offv00 = vb_ + ((cv_ ^ xk_) << 4), offv01 = vb_ + (((cv_ + 2) ^ xk_) << 4), offv10 = vb_ + (((cv_ + 4) ^ xk_) << 4), offv11 = vb_ + (((cv_ + 6) ^ xk_) << 4);
    const int lrow = tid >> 3, gch = (tid & 7) ^ ((lrow >> 1) & 7);
#define NSA_DMA(I, BUF) do { const bf16_t* kp_; const bf16_t* vp_; int ldk_, ldv_; NSA_TILE_SRC((I), kp_, ldk_, vp_, ldv_); \
    __builtin_amdgcn_global_load_lds((const unsigned*)(kp_ + (size_t)lrow * ldk_ + gch * 8), (LAS unsigned*)(lds + (BUF) * 16384 + wave * 1024), 16, 0, 0); \
    __builtin_amdgcn_global_load_lds((const unsigned*)(vp_ + (size_t)lrow * ldv_ + gch * 8), (LAS unsigned*)(lds + (BUF) * 16384 + 8192 + wave * 1024), 16, 0, 0); } while (0)
    NSA_DMA(0, 0);
    { const int i1_ = 1 < NT ? 1 : NT - 1, i2_ = 2 < NT ? 2 : NT - 1; NSA_DMA(i1_, 1); NSA_DMA(i2_, 2); }
    { const f32x4 z_ = zero4;
#pragma unroll
      for (int q_ = 0; q_ < 4; ++q_) *(LAS f32x4*)(wA + q_ * 256 + lane * 4) = z_; }
    int pb = 0;
    const int NP = (NT + 2) / 3;
    for (int p = 0; p < NP; ++p) {
        asm volatile("s_waitcnt vmcnt(0)" ::: "memory");
        __builtin_amdgcn_s_barrier();
        asm volatile("" ::: "memory");
        { const int ia_ = 3 * p + 3 < NT ? 3 * p + 3 : NT - 1, ib_ = 3 * p + 4 < NT ? 3 * p + 4 : NT - 1, ic_ = 3 * p + 5 < NT ? 3 * p + 5 : NT - 1; const int bn_ = 3 - pb; NSA_DMA(ia_, bn_); NSA_DMA(ib_, bn_ + 1); NSA_DMA(ic_, bn_ + 2); }
        const int pbc = pb; pb = 3 - pb;
#pragma unroll 1
      for (int u = 0; u < 3; ++u) { const int i = 3 * p + u; if (i >= NT) break;
        const LAS unsigned char* kbuf = lds + (pbc + u) * 16384; const LAS unsigned char* vbuf = kbuf + 8192;
        bf16x8 ka[4], kb[4]; u32x4 vf[2][4], pf[2][2]; f32x4 S[4];
        if (i < nc) {
            const int kb0 = i * 64; const bool n0 = kb0 < nv[0], n1 = kb0 < nv[1];
            if (n0 || n1) { nsa_loadk(kbuf, offk0, offk1, ka, kb);
#pragma unroll
                for (int r = 0; r < 2; ++r) if (r == 0 ? n0 : n1) { nsa_scores(ka, kb, q0[r], q1[r], S);
#pragma unroll
                    for (int st = 0; st < 4; ++st)
#pragma unroll
                        for (int j = 0; j < 4; ++j) { const float e = __builtin_amdgcn_exp2f(S[st][j]); l[r] += (kb0 + st * 16 + 4 * fq + j < nvl[r]) ? e : 0.f; } } }
            if (i == nc - 1) {
#pragma unroll
                for (int r = 0; r < 2; ++r) { l[r] = x16sum(l[r]); l[r] = x32sum(l[r]); il[r] = l[r] > 0.f ? 1.0f / l[r] : 0.f; } }
        } else if (i < 2 * nc) {
            const int kb0 = (i - nc) * 64; const bool n0 = kb0 < nv[0], n1 = kb0 < nv[1];
            if (n0 || n1) { nsa_loadk(kbuf, offk0, offk1, ka, kb);
#pragma unroll
                for (int r = 0; r < 2; ++r) if (r == 0 ? n0 : n1) { nsa_scores(ka, kb, q0[r], q1[r], S);
#pragma unroll
                    for (int st = 0; st < 4; ++st)
#pragma unroll
                        for (int j = 0; j < 4; ++j) { const float e = __builtin_amdgcn_exp2f(S[st][j]) * il[r]; S[st][j] = (kb0 + st * 16 + 4 * fq + j < nvl[r]) ? e : 0.f; }
#pragma unroll
                    for (int st = 0; st < 4; ++st) { const int sb = (kb0 >> 2) + 4 * st + fq; const float hb = 0.5f * S[st][3];
                        const float a = quadsum((S[st][0] + S[st][1]) + (S[st][2] + hb)), b = quadsum(hb);
                        if (h == 0) { LAS float* wp = wA + (r * 4 + ti) * 128 + sb; (void)__hip_atomic_fetch_add(wp, a, __ATOMIC_RELAXED, __HIP_MEMORY_SCOPE_WORKGROUP); if (sb + 1 < 128) (void)__hip_atomic_fetch_add(wp + 1, b, __ATOMIC_RELAXED, __HIP_MEMORY_SCOPE_WORKGROUP); } }
                    nsa_pack(S, pf[r]); }
                nsa_loadv(vbuf, offv00, offv01, offv10, offv11, vf);
#pragma unroll
                for (int r = 0; r < 2; ++r) if (r == 0 ? n0 : n1) nsa_pv(vf, pf[r], O[r]); }
            if (i == 2 * nc - 1) {
#pragma unroll
                for (int r = 0; r < 2; ++r) {
#pragma unroll
                    for (int dt = 0; dt < 4; ++dt) { *(f32x4*)(accb + (size_t)t[r] * 1024 + (g * 4 + h) * 64 + dt * 16 + 4 * fq) = O[r][dt] * gate_c[r]; O[r][dt] = zero4; }
                    l[r] = 0.f; }
                if (cur < 16) { if (lane < 32) wM[lane] = (lane & 3) == 0 ? ((2u << cur) - 1u) : 0u;
                } else {
                    LDS_WAIT();
#pragma unroll
                    for (int r = 0; r < 2; ++r) {
#pragma unroll
                        for (int tk = 0; tk < 4; ++tk) { const LAS float* wa = wA + (r * 4 + tk) * 128;
                            unsigned k0, k1;
                            { const int s0 = lane, s1 = lane + 64; const float sc0 = wa[s0], sc1 = wa[s1];
                              const bool f0 = (s0 == 0) || (s0 == cur) || (s0 == cur - 1), f1 = (s1 == cur) || (s1 == cur - 1);
                              k0 = f0 ? __float_as_uint(FORCE) : (s0 <= cur ? __float_as_uint(sc0) : 0u); k1 = f1 ? __float_as_uint(FORCE) : (s1 <= cur ? __float_as_uint(sc1) : 0u); }
                            unsigned T = 0u;
                            for (int bit = 30; bit >= 0; --bit) { const unsigned cand = T | (1u << bit);
                                const int cnt = __builtin_popcountll(__ballot(k0 >= cand)) + __builtin_popcountll(__ballot(k1 >= cand)); T = cnt >= 16 ? cand : T; }
                            const unsigned long long g0 = __ballot(k0 > T), g1 = __ballot(k1 > T), e0 = __ballot(k0 == T), e1 = __ballot(k1 == T);
                            const int need = 16 - (__builtin_popcountll(g0) + __builtin_popcountll(g1));
                            const int rk0 = (int)__builtin_amdgcn_mbcnt_hi((unsigned)(e0 >> 32), __builtin_amdgcn_mbcnt_lo((unsigned)e0, 0u));
                            const int rk1 = __builtin_popcountll(e0) + (int)__builtin_amdgcn_mbcnt_hi((unsigned)(e1 >> 32), __builtin_amdgcn_mbcnt_lo((unsigned)e1, 0u));
                            const bool sel0 = (k0 > T) || (k0 == T && rk0 < need), sel1 = (k1 > T) || (k1 == T && rk1 < need);
                            const unsigned long long lo = __ballot(sel0 && lane <= cur), hi = __ballot(sel1 && lane + 64 <= cur);
                            if (lane == 0) { LAS unsigned* mw = wM + (r * 4 + tk) * 4; mw[0] = (unsigned)lo; mw[1] = (unsigned)(lo >> 32); mw[2] = (unsigned)hi; mw[3] = (unsigned)(hi >> 32); } }
                    }
                    LDS_WAIT();
                }
            }
        } else if (i < 2 * nc + cur + 1) {
            const int s = i - 2 * nc, kb0 = s * 64;
            bool any[2], mine[2], all4[2];
            const unsigned mwd0 = wM[ti * 4 + (s >> 5)], mwd1 = wM[(4 + ti) * 4 + (s >> 5)];
            nsa_loadk(kbuf, offk0, offk1, ka, kb);
#pragma unroll
            for (int r = 0; r < 2; ++r) { const unsigned mwd = r == 0 ? mwd0 : mwd1; mine[r] = ((mwd >> (s & 31)) & 1u) != 0u; const unsigned long long bal = __ballot(mine[r]); any[r] = bal != 0ull && kb0 <= tmax[r]; all4[r] = bal == ~0ull; }
            if (any[0] || any[1]) {
#pragma unroll
                for (int r = 0; r < 2; ++r) if (any[r]) { nsa_scores(ka, kb, q0[r], q1[r], S);
                    if (kb0 + 63 <= t0[r]) { if (all4[r]) tile_softmax<0>(S, true, 0, 0, 0u, l[r]); else tile_softmax<1>(S, mine[r], 0, 0, 0u, l[r]); }
                    else tile_softmax<2>(S, false, kb0 + 4 * fq, mine[r] ? 0 : 0x40000000, (unsigned)t[r], l[r]);
                    nsa_pack(S, pf[r]); }
                nsa_loadv(vbuf, offv00, offv01, offv10, offv11, vf);
#pragma unroll
                for (int r = 0; r < 2; ++r) if (any[r]) nsa_pv(vf, pf[r], O[r]); }
            if (s == cur) {
#pragma unroll
                for (int r = 0; r < 2; ++r) { l[r] = x16sum(l[r]); l[r] = x32sum(l[r]); const float sc = (l[r] > 0.f ? 1.0f / l[r] : 0.f) * gate_s[r];
#pragma unroll
                    for (int dt = 0; dt < 4; ++dt) { f32x4* ap = (f32x4*)(accb + (size_t)t[r] * 1024 + (g * 4 + h) * 64 + dt * 16 + 4 * fq); *ap = *ap + O[r][dt] * sc; O[r][dt] = zero4; }
                    l[r] = 0.f; } }
        } else {
            const int kb0 = (ws0 + i - (2 * nc + cur + 1)) * 64;
            bool need[2];
#pragma unroll
            for (int r = 0; r < 2; ++r) need[r] = kb0 <= tmax[r] && kb0 + 63 + 512 > t0[r];
            if (need[0] || need[1]) { nsa_loadk(kbuf, offk0, offk1, ka, kb);
#pragma unroll
                for (int r = 0; r < 2; ++r) if (need[r]) { nsa_scores(ka, kb, q0[r], q1[r], S);
                    if (kb0 + 512 > tmax[r] && kb0 + 63 <= t0[r]) tile_softmax<0>(S, true, 0, 0, 0u, l[r]);
                    else tile_softmax<2>(S, false, kb0 + 4 * fq, t[r] - 511, 511u, l[r]);
                    nsa_pack(S, pf[r]); }
                nsa_loadv(vbuf, offv00, offv01, offv10, offv11, vf);
#pragma unroll
                for (int r = 0; r < 2; ++r) if (need[r]) nsa_pv(vf, pf[r], O[r]); }
        }
      }
    }
    asm volatile("s_waitcnt vmcnt(0)" ::: "memory"); __builtin_amdgcn_s_barrier(); asm volatile("" ::: "memory");
#undef NSA_DMA
#pragma unroll
    for (int r = 0; r < 2; ++r) { l[r] = x16sum(l[r]); l[r] = x32sum(l[r]);
        const float sc = (l[r] > 0.f ? 1.0f / l[r] : 0.f) * gate_w[r];
#pragma unroll
        for (int dt = 0; dt < 4; ++dt) O[r][dt] = *(const f32x4*)(accb + (size_t)t[r] * 1024 + (g * 4 + h) * 64 + dt * 16 + 4 * fq) + O[r][dt] * sc;
        bf16_t* op = zb + (size_t)t[r] * ZM + ZC_Q + (g * 4 + h) * 64 + 4 * fq;
#pragma unroll
        for (int dt = 0; dt < 4; ++dt) { u32x2 w; w.x = cvt_pk_bf16(O[r][dt][0], O[r][dt][1]); w.y = cvt_pk_bf16(O[r][dt][2], O[r][dt][3]); *(u32x2*)(op + dt * 16) = w; } }
}

__device__ __forceinline__ void mem_task(bf16_t* zb, const bf16_t* kvm_b, const bf16_t* vmt_b, int hm, int t0, int lane, bool do_store) {
    const int n = lane & 15, fq = lane >> 4;
    bf16_t* qp = zb + (size_t)(t0 + n) * ZM + ZC_QM + hm * 256;
    bf16x8 qf[8];
#pragma unroll
    for (int kk = 0; kk < 8; ++kk) qf[kk] = *(const bf16x8*)(qp + kk * 32 + 8 * fq);
    f32x4 zero4 = {0.f, 0.f, 0.f, 0.f}; asm volatile("" : "+v"(zero4));
    f32x4 s[16];
    const bf16_t* kbase = kvm_b + (size_t)(8 * (n >> 2) + (n & 3)) * 2048 + hm * 256 + 8 * fq;
    bf16x8 kfr[3][8];
#pragma unroll
    for (int kk = 0; kk < 8; ++kk) kfr[0][kk] = *(const bf16x8*)(kbase + kk * 32);
    { const bf16_t* kp = kbase + (size_t)4 * 2048;
#pragma unroll
      for (int kk = 0; kk < 8; ++kk) kfr[1][kk] = *(const bf16x8*)(kp + kk * 32); }
#pragma unroll
    for (int kt = 0; kt < 16; ++kt) {
        if (kt + 2 < 16) { const bf16_t* kp = kbase + (size_t)(((kt + 2) >> 1) * 32 + 4 * ((kt + 2) & 1)) * 2048;
#pragma unroll
            for (int kk = 0; kk < 8; ++kk) kfr[(kt + 2) % 3][kk] = *(const bf16x8*)(kp + kk * 32); }
        f32x4 acc = zero4;
#pragma unroll
        for (int kk = 0; kk < 8; ++kk) acc = mfma16(kfr[kt % 3][kk], qf[kk], acc);
        s[kt] = acc; }
    float l = 0.f;
#pragma unroll
    for (int kt = 0; kt < 16; ++kt)
#pragma unroll
        for (int j = 0; j < 4; ++j) { s[kt][j] = __builtin_amdgcn_exp2f(s[kt][j]); l += s[kt][j]; }
    l = x16sum(l); l = x32sum(l);
    const float il = 1.0f / l;
    bf16x8 pf[8];
#pragma unroll
    for (int kp = 0; kp < 8; ++kp) { u32x4 w; w.x = cvt_pk_bf16(s[2 * kp][0], s[2 * kp][1]); w.y = cvt_pk_bf16(s[2 * kp][2], s[2 * kp][3]); w.z = cvt_pk_bf16(s[2 * kp + 1][0], s[2 * kp + 1][1]); w.w = cvt_pk_bf16(s[2 * kp + 1][2], s[2 * kp + 1][3]); pf[kp] = __builtin_bit_cast(bf16x8, w); }
    const bf16_t* vbase = vmt_b + (size_t)(hm * 256 + n) * 256 + 8 * fq;
    bf16x8 vfr[3][8];
#pragma unroll
    for (int kp = 0; kp < 8; ++kp) vfr[0][kp] = *(const bf16x8*)(vbase + kp * 32);
    { const bf16_t* vp = vbase + (size_t)16 * 256;
#pragma unroll
      for (int kp = 0; kp < 8; ++kp) vfr[1][kp] = *(const bf16x8*)(vp + kp * 32); }
#pragma unroll
    for (int dt = 0; dt < 16; ++dt) {
        if (dt + 2 < 16) { const bf16_t* vp = vbase + (size_t)((dt + 2) * 16) * 256;
#pragma unroll
            for (int kp = 0; kp < 8; ++kp) vfr[(dt + 2) % 3][kp] = *(const bf16x8*)(vp + kp * 32); }
        f32x4 acc = zero4;
#pragma unroll
        for (int kp = 0; kp < 8; ++kp) acc = mfma16(vfr[dt % 3][kp], pf[kp], acc);
        u32x2 w; w.x = cvt_pk_bf16(acc[0] * il, acc[1] * il); w.y = cvt_pk_bf16(acc[2] * il, acc[3] * il); if (do_store || acc[0] == 12345.678f) *(u32x2*)(qp + dt * 16 + 4 * fq) = w; }
}

struct Args { const float* in[29]; float* out; unsigned char* ws; int ph_lo, ph_hi; };
enum { I_X = 0, I_MEM, I_F1N, I_F1G, I_F1U, I_F1D, I_MIXN, I_MEMNORM, I_WIN, I_CONVW, I_GQ, I_GKC, I_GKS, I_GKW, I_PEK, I_W1K, I_W2K, I_PEV, I_W1V, I_W2V, I_WMKV, I_GMQ, I_GMK, I_WBR, I_WO, I_F2N, I_F2G, I_F2U, I_F2D };

#define XB_TMO      128
#define XB_XCNT(j)  (256  + 64 * (j))
#define XB_XSUB(j)  (1280 + 64 * (j))
#define XB_XGEN(j)  (2304 + 64 * (j))
#define XB_TOP      3328
#define XB_TOPGEN   3392
#define XCD_BAR_WORDS 3456
#define XB_SPIN_CAP (1u << 18)

__device__ __forceinline__ unsigned xb_ld(unsigned* p)              { return __hip_atomic_load(p, __ATOMIC_RELAXED, __HIP_MEMORY_SCOPE_AGENT); }
__device__ __forceinline__ unsigned xb_add(unsigned* p, unsigned v) { return __hip_atomic_fetch_add(p, v, __ATOMIC_RELAXED, __HIP_MEMORY_SCOPE_AGENT); }
__device__ __forceinline__ unsigned xb_xcc_id() { return (unsigned)__builtin_amdgcn_s_getreg((3 << 11) | 20) & 0xFu; }
#define XB_SPIN(cond, bar) do { unsigned _sp = 0; while (cond) { __builtin_amdgcn_s_sleep(1); \
    if ((++_sp & 255u) == 0u) { if (xb_ld(&(bar)[XB_TMO])) break; if (_sp > XB_SPIN_CAP) { atomicAdd(&(bar)[XB_TMO], 1u); break; } } } } while (0)

struct XcdBarrier {
    unsigned* bar; unsigned x;
    volatile LAS unsigned* st;
};

__device__ __forceinline__ XcdBarrier xcd_barrier_post(unsigned* bar, volatile LAS unsigned* st) {
    XcdBarrier b; b.bar = bar; b.x = xb_xcc_id(); b.st = st;
    if (threadIdx.x == 0) (void)xb_add(&bar[XB_XCNT(b.x)], 1u);
    return b;
}
__device__ __forceinline__ void xcd_barrier_complete(unsigned* bar, unsigned x, unsigned& nloc, unsigned& nx) {
    const unsigned G = gridDim.x * gridDim.y * gridDim.z;
    unsigned sum, cnt, mine, sp = 0u;
    for (;;) {
        sum = 0u; cnt = 0u; mine = 0u;
#pragma unroll
        for (unsigned j = 0; j < 16; ++j) { const unsigned c = xb_ld(&bar[XB_XCNT(j)]); sum += c; cnt += (c > 0u) ? 1u : 0u; mine = (j == x) ? c : mine; }
        if (sum == G) break;
        __builtin_amdgcn_s_sleep(1);
        if ((++sp & 255u) == 0u) { if (xb_ld(&bar[XB_TMO])) break; if (sp > XB_SPIN_CAP) { atomicAdd(&bar[XB_TMO], 1u); break; } }
    }
    nloc = mine > 0u ? mine : 1u; nx = cnt > 0u ? cnt : 1u;
}

__device__ __forceinline__ void xcd_barrier(const XcdBarrier& b, bool is_thread0) {
    asm volatile("s_waitcnt vmcnt(0)" ::: "memory");
    __syncthreads();
    if (is_thread0) {
        unsigned* bar = b.bar;
        __builtin_amdgcn_s_waitcnt(0);
        unsigned nloc = b.st[0], nx = b.st[1];
        if (nloc == 0u) { xcd_barrier_complete(bar, b.x, nloc, nx); b.st[0] = nloc; b.st[1] = nx; }
        const unsigned old = xb_add(&bar[XB_XSUB(b.x)], 1u);
        const unsigned gen = old / nloc;
        if (old + 1u == (gen + 1u) * nloc) {
            __builtin_amdgcn_fence(__ATOMIC_RELEASE, "agent");
            asm volatile("s_waitcnt vmcnt(0)" ::: "memory");
            const unsigned og = xb_add(&bar[XB_TOP], 1u);
            const unsigned tg = og / nx;
            if (og + 1u == (tg + 1u) * nx) xb_add(&bar[XB_TOPGEN], 1u);
            else XB_SPIN(xb_ld(&bar[XB_TOPGEN]) == tg, bar);
            __builtin_amdgcn_fence(__ATOMIC_ACQUIRE, "agent");
            xb_add(&bar[XB_XGEN(b.x)], 1u);
            asm volatile("s_waitcnt vmcnt(0)" ::: "memory");
        } else {
            XB_SPIN(xb_ld(&bar[XB_XGEN(b.x)]) == gen, bar);
            __builtin_amdgcn_fence(__ATOMIC_ACQUIRE, "agent");
            asm volatile("s_waitcnt vmcnt(0)" ::: "memory");
        }
    }
    __syncthreads();
}

__device__ __forceinline__ int fresh_lane() { unsigned m_ = ~0u; asm volatile("" : "+s"(m_)); return (int)__builtin_amdgcn_mbcnt_hi(m_, __builtin_amdgcn_mbcnt_lo(m_, 0u)); }
__device__ __forceinline__ const void* ldp(LAS unsigned long long* tab, int i) { const unsigned long long v = tab[i]; const unsigned lo = __builtin_amdgcn_readfirstlane((unsigned)v), hi = __builtin_amdgcn_readfirstlane((unsigned)(v >> 32)); return (const void*)(const __attribute__((address_space(1))) void*)(((unsigned long long)hi << 32) | lo); }
#define INP(i) ((const float*)ldp(tab, (i)))
__global__ void __launch_bounds__(512, 2) mega(Args a) {
    extern __shared__ __attribute__((aligned(16))) unsigned char lds_raw[];
    LAS unsigned char* lds = (LAS unsigned char*)lds_raw;
    const int tid0 = threadIdx.x; const int wave0 = __builtin_amdgcn_readfirstlane(tid0 >> 6);
    LAS unsigned long long* tab = (LAS unsigned long long*)(lds + 131072);
    if (tid0 == 0) {
        tab[0] = (unsigned long long)a.in[0]; tab[1] = (unsigned long long)a.in[1]; tab[2] = (unsigned long long)a.in[2]; tab[3] = (unsigned long long)a.in[3]; tab[4] = (unsigned long long)a.in[4];
        tab[5] = (unsigned long long)a.in[5]; tab[6] = (unsigned long long)a.in[6]; tab[7] = (unsigned long long)a.in[7]; tab[8] = (unsigned long long)a.in[8]; tab[9] = (unsigned long long)a.in[9];
        tab[10] = (unsigned long long)a.in[10]; tab[11] = (unsigned long long)a.in[11]; tab[12] = (unsigned long long)a.in[12]; tab[13] = (unsigned long long)a.in[13]; tab[14] = (unsigned long long)a.in[14];
        tab[15] = (unsigned long long)a.in[15]; tab[16] = (unsigned long long)a.in[16]; tab[17] = (unsigned long long)a.in[17]; tab[18] = (unsigned long long)a.in[18]; tab[19] = (unsigned long long)a.in[19];
        tab[20] = (unsigned long long)a.in[20]; tab[21] = (unsigned long long)a.in[21]; tab[22] = (unsigned long long)a.in[22]; tab[23] = (unsigned long long)a.in[23]; tab[24] = (unsigned long long)a.in[24];
        tab[25] = (unsigned long long)a.in[25]; tab[26] = (unsigned long long)a.in[26]; tab[27] = (unsigned long long)a.in[27]; tab[28] = (unsigned long long)a.in[28];
        tab[29] = (unsigned long long)a.out; tab[30] = (unsigned long long)a.ws; tab[31] = ((unsigned long long)(unsigned)a.ph_hi << 32) | (unsigned)a.ph_lo;
        ((volatile LAS unsigned*)(lds + 131072 + 512))[0] = 0u; ((volatile LAS unsigned*)(lds + 131072 + 512))[1] = 0u;
    }
    __syncthreads();
    if (a.ph_hi - a.ph_lo > 1) (void)xcd_barrier_post((unsigned*)a.ws, (volatile LAS unsigned*)(lds + 131072 + 512));
    cg::grid_group grid = cg::this_grid();

    for (int ph = a.ph_lo; ; ++ph) {
        asm volatile("" ::: "memory");
        const int ph_hi = __builtin_amdgcn_readfirstlane((int)(tab[31] >> 32));
        if (ph >= ph_hi) break;
        int wave_ = wave0; asm volatile("" : "+s"(wave_)); const int wave = wave_;
        const int lane = fresh_lane();
        int G_ = gridDim.x, cb_ = blockIdx.x; asm volatile("" : "+s"(G_), "+s"(cb_)); const int G = G_, cb = cb_, gw = cb * 8 + wave, NGW = G * 8;
        unsigned char* ws = (unsigned char*)ldp(tab, 30); float* const OUTP = (float*)ldp(tab, 29);
        bf16_t* const WIN_T = (bf16_t*)(ws + WS_WIN); bf16_t* const WMK_T = (bf16_t*)(ws + WS_WMK); bf16_t* const WBR_T = (bf16_t*)(ws + WS_WBR); bf16_t* const WO_T = (bf16_t*)(ws + WS_WO);
        bf16_t* const WC1_T = (bf16_t*)(ws + WS_WC1); float* const BIASC = (float*)(ws + WS_BIASC); bf16_t* const MEMN = (bf16_t*)(ws + WS_MEMN); bf16_t* const KVM = (bf16_t*)(ws + WS_KVM); bf16_t* const VMT = (bf16_t*)(ws + WS_VMT);
        bf16_t* const WGU1 = (bf16_t*)(ws + WS_WGU1); bf16_t* const WD1 = (bf16_t*)(ws + WS_WD1); bf16_t* const WGU2 = (bf16_t*)(ws + WS_WGU2); bf16_t* const WD2 = (bf16_t*)(ws + WS_WD2);
        bf16_t* const H = (bf16_t*)(ws + WS_H); float* const MF = (float*)(ws + WS_MF); bf16_t* const ACT = (bf16_t*)(ws + WS_ACT);
        bf16_t* const ZMAIN = (bf16_t*)(ws + WS_ZMAIN); bf16_t* const ZGATE = (bf16_t*)(ws + WS_ZGATE); bf16_t* const VST = (bf16_t*)(ws + WS_VST); bf16_t* const VWT = (bf16_t*)(ws + WS_VWT);
        bf16_t* const HID = (bf16_t*)(ws + WS_HID); bf16_t* const KC = (bf16_t*)(ws + WS_KC); bf16_t* const VCT = (bf16_t*)(ws + WS_VCT);
        int kind, b = 0, f = 0;
        if (ph < 4) kind = ph; else if (ph < 16) { b = (ph - 4) / 6; kind = 4 + (ph - 4) % 6; } else { f = 1; kind = ph == 16 ? 3 : (ph == 17 ? 1 : 2); }
        if (kind == 9) kind = 2;
        const size_t boff = (size_t)b * SEQ;

#ifndef PROBE_PRO
#define PROBE_PRO 1
#endif
#ifndef PROBE_GU
#define PROBE_GU 1
#endif
#ifndef PROBE_CMP
#define PROBE_CMP 1
#endif
#ifndef PROBE_TOK
#define PROBE_TOK 1
#endif
#ifndef PROBE_VTR
#define PROBE_VTR 1
#endif
#ifndef PROBE_CL2
#define PROBE_CL2 1
#endif
#ifndef PROBE_Z
#define PROBE_Z 1
#endif
#ifndef PROBE_MERGE
#define PROBE_MERGE 1
#endif
#ifndef PROBE_NORM
#define PROBE_NORM 1
#endif
#ifndef PROBE_SYNC
#define PROBE_SYNC 1
#endif
#ifndef PROBE_NSA_SKIPC
#define PROBE_NSA_SKIPC 0
#endif
#ifndef PROBE_NSA
#define PROBE_NSA 1
#endif
#ifndef PROBE_C2
#define PROBE_C2 1
#endif
        if (kind == 0) for (int prep_ = 0; prep_ < PROBE_PRO; ++prep_) {
            LAS float* scr = (LAS float*)(lds + wave * 16384);
            int total = 0;
#define SEGN(ncols, K) (((K) / 64) * (((ncols) + 31) / 32))
            constexpr int N_F = SEGN(5632, 2048), N_D = SEGN(2048, 5632);
            constexpr int NIT = 2 * N_F + N_D + SEGN(1024, 2048) * 5 + SEGN(1536, 2048) + SEGN(48, 2048) + SEGN(6144, 2048) + SEGN(2048, 2048) + 2 * SEGN(256, 2048);
            (void)total;
            for (int it = gw; it < NIT; it += NGW) {
                int r = it;
#define SEG(W, ldw, col0, ncols, K, WT, row0, mode) { constexpr int ni_ = SEGN(ncols, K); if (r < ni_) { tr_item((W), (ldw), (col0), (ncols), (K), (WT), (row0), (mode), scr, r, lane); continue; } r -= ni_; }
                SEG(INP(I_F1G), DFF, 0, 5632, 2048, WGU1, 0, 1)
                SEG(INP(I_F1U), DFF, 0, 5632, 2048, WGU1, 128, 1)
                SEG(INP(I_F1D), DM, 0, 2048, 5632, WD1, 0, 0)
                SEG(INP(I_WIN), 12848, 0, 1024, 2048, WIN_T, ZC_B, 0)
                SEG(INP(I_WIN), 12848, 3072, 1024, 2048, WIN_T, ZC_Q, 0)
                SEG(INP(I_WIN), 12848, 5680, 1024, 2048, WIN_T, ZC_QM, 0)
                SEG(INP(I_WIN), 12848, 1024, 1024, 2048, WIN_T, ZC_C, 0)
                SEG(INP(I_WIN), 12848, 2048, 1024, 2048, WIN_T, ZC_U, 0)
                SEG(INP(I_WIN), 12848, 4096, 1536, 2048, WIN_T, ZC_KC, 0)
                SEG(INP(I_WIN), 12848, 5632, 48, 2048, WIN_T, ZC_G, 0)
                SEG(INP(I_WIN), 12848, 6704, 6144, 2048, WIN_T, ZM, 0)
                SEG(INP(I_WMKV), 2048, 0, 2048, 2048, WMK_T, 0, 0)
                SEG(INP(I_W1K), 256, 0, 256, 2048, WC1_T, 0, 0)
                SEG(INP(I_W1V), 256, 0, 256, 2048, WC1_T, 256, 0)
            }
            { u32x4* p = (u32x4*)(WIN_T + (size_t)(ZC_G + 48) * 2048); const int n16 = (ZM - ZC_G - 48) * 2048 * 2 / 16; const u32x4 z4 = {0u, 0u, 0u, 0u};
                for (int i = cb * 512 + ((wave << 6) | lane); i < n16; i += G * 512) p[i] = z4; }
            for (int m = gw; m < MTOK; m += NGW) rms_row(INP(I_X) + (size_t)m * DM, INP(I_F1N), H + (size_t)m * DM, lane);
            for (int m = gw; m < 512; m += NGW) rms_row(INP(I_MEM) + (size_t)m * DM, INP(I_MEMNORM), MEMN + (size_t)m * DM, lane);
            for (int tk = gw; tk < 512; tk += NGW) { const int kv = tk >> 8, j = tk & 255; const float* pe = INP(kv ? I_PEV : I_PEK); const float* w1 = INP(kv ? I_W1V : I_W1K);
                float acc = 0.f;
#pragma unroll 8
                for (int i = 0; i < 32; ++i) { const int k = lane + 64 * i; acc += pe[k] * w1[(size_t)k * 256 + j]; }
                acc = wave_sum(acc);
                if (lane == 0) BIASC[kv * 256 + j] = acc; }
        }
        else if (kind == 1) {
            pg8::Gemm g{H, f ? WGU2 : WGU1, MTOK, 2 * DFF, DM, DM, 0, DM}; pg8::Order S; S.init(MTOK, 2 * DFF, G, cb, 0);
            pg8::EpiSwiGLU E{ACT, DFF};
            for (int prep_ = 0; prep_ < PROBE_GU; ++prep_) pg8::gemm_phase<pg8::EpiSwiGLU, pg8::Order, true, true>(lds, g, S, E, wave);
        }
        else if (kind == 2) {
            const bool wo = (ph >= 4 && ph < 16);
            pg8::Gemm g{wo ? H + boff * DM : ACT, wo ? WO_T : (f ? WD2 : WD1), wo ? SEQ : MTOK, DM, wo ? DM : DFF, wo ? DM : DFF, 0, wo ? DM : DFF};
            pg8::Order S; S.init(g.M, DM, G, cb, 0);
            const float* base = wo ? OUTP + boff * DM : (f ? OUTP : INP(I_X));
            pg8::EpiResid E{base, wo ? OUTP + boff * DM : OUTP, DM, wo ? 1.0f : 0.5f};
            pg8::gemm_phase<pg8::EpiResid, pg8::Order, true, true>(lds, g, S, E, wave);
        }
        else if (kind == 3) {
            const float* gain = INP(f ? I_F2N : I_MIXN);
            for (int prep_ = 0; prep_ < PROBE_NORM; ++prep_) for (int m = gw; m < MTOK; m += NGW) rms_row(OUTP + (size_t)m * DM, gain, H + (size_t)m * DM, lane);
        }
        else if (kind == 4) {
            const int nrep = b == 0 ? 2 : 1;
            for (int rep = 0; rep < nrep; ++rep) {
                pg8::Gemm g{rep ? MEMN : H + boff * DM, rep ? WMK_T : WIN_T, rep ? 512 : SEQ, rep ? 2048 : 13056, DM, DM, 0, DM}; pg8::Order S; S.init(g.M, g.N, G, rep ? (cb + G - 96) % G : cb, 0);
                pg8::EpiStore E{rep ? KVM : ZMAIN, rep ? 2048 : ZM, rep ? 8 : NZ0, ZGATE, ZG};
                for (int prep_ = 0; prep_ < PROBE_Z; ++prep_) pg8::gemm_phase<pg8::EpiStore, pg8::Order, true, true>(lds, g, S, E, wave);
            }
            if (G != 256 || cb >= 112) { LAS float* scr = (LAS float*)(lds + wave * 16384); const int lane = fresh_lane(); const int gw3 = G == 256 ? (cb - 112) * 8 + wave : gw, NGW3 = G == 256 ? (G - 112) * 8 : NGW;
                if (b == 0) { constexpr int NITZ = SEGN(5632, 2048) + 3 * SEGN(2048, 1024) + SEGN(2048, 2048);
                    for (int it = gw3; it < NITZ; it += NGW3) { int r = it;
                        SEG(INP(I_WBR), 2048, 0, 2048, 1024, WBR_T, 0, 0)
                        SEG(INP(I_WBR) + (size_t)1024 * 2048, 2048, 0, 2048, 1024, WBR_T, 2048, 0)
                        SEG(INP(I_WBR) + (size_t)2 * 1024 * 2048, 2048, 0, 2048, 1024, WBR_T, 4096, 0)
                        SEG(INP(I_WO), 2048, 0, 2048, 2048, WO_T, 0, 0)
                        SEG(INP(I_F2G), DFF, 0, 5632, 2048, WGU2, 0, 1)
                    } }
                else { constexpr int NITZ = SEGN(5632, 2048) + SEGN(2048, 5632);
                    for (int it = gw3; it < NITZ; it += NGW3) { int r = it;
                        SEG(INP(I_F2U), DFF, 0, 5632, 2048, WGU2, 128, 1)
                        SEG(INP(I_F2D), DM, 0, 2048, 5632, WD2, 0, 0)
                    } } }
        }
        else if (kind == 5) {
            {
                pg8::Gemm g{ZMAIN, WC1_T, 2048, 512, DM, ZM, 1, DM}; pg8::Order S; S.init(2048, 512, G, cb, 2); S.a1off = ZC_KC * 2; S.a2off = ZC_VC * 2;
                pg8::EpiCmp E{HID, BIASC, 2044};
                for (int prep_ = 0; prep_ < PROBE_CMP; ++prep_) pg8::gemm_phase<pg8::EpiCmp, pg8::Order, true, true>(lds, g, S, E, wave);
            }
            const int lane = fresh_lane();
            const bool split_ = G > 32; const int gw2 = split_ ? (cb - 16) * 8 + wave : gw, NGW2 = split_ ? (G - 16) * 8 : NGW;
            if (!split_ || cb >= 16) {
            for (int prep_ = 0; prep_ < PROBE_TOK; ++prep_) for (int t = gw2; t < SEQ; t += NGW2) tok_prep(ZMAIN, t, INP(I_CONVW), INP(I_GQ), INP(I_GKS), INP(I_GKW), INP(I_GMQ), lane, prep_ == PROBE_TOK - 1);
            for (int prep_ = 0; prep_ < PROBE_VTR; ++prep_) for (int it = gw2; it < 128 * 64; it += NGW2) { const int tg = it >> 6, ch = it & 63, t = tg * 64 + lane; const int src = (ch < 32 ? ZC_VS : ZC_VW) + (ch & 31) * 8;
                float v[8]; unpack8(*(const u32x4*)(ZMAIN + (size_t)t * ZM + src), v); bf16_t* dst = (ch < 32 ? VST : VWT) + (size_t)((ch & 31) * 8) * SEQ + t;
                const u32x4 w = *(const u32x4*)(ZMAIN + (size_t)t * ZM + src);
                dst[0 * SEQ] = (bf16_t)(w.x & 0xffffu); dst[1 * SEQ] = (bf16_t)(w.x >> 16); dst[2 * SEQ] = (bf16_t)(w.y & 0xffffu); dst[3 * SEQ] = (bf16_t)(w.y >> 16);
                dst[4 * (size_t)SEQ] = (bf16_t)(w.z & 0xffffu); dst[5 * (size_t)SEQ] = (bf16_t)(w.z >> 16); dst[6 * (size_t)SEQ] = (bf16_t)(w.w & 0xffffu); dst[7 * (size_t)SEQ] = (bf16_t)(w.w >> 16); (void)v; }
            if (b == 0) {
                const float* gk = INP(I_GMK);
                for (int it = gw2; it < 512 * 4; it += NGW2) { const int r = it >> 2, hh = it & 3; bf16_t* p = KVM + (size_t)r * 2048 + hh * 256 + lane * 4; const u32x2 w = *(const u32x2*)p;
                    const float v0 = bflo(w.x), v1 = bfhi(w.x), v2 = bflo(w.y), v3 = bfhi(w.y);
                    const float rr = 1.0f / sqrtf(wave_sum(v0 * v0 + v1 * v1 + v2 * v2 + v3 * v3) * (1.0f / 256.0f) + EPS);
                    u32x2 o; o.x = cvt_pk_bf16(v0 * rr * gk[lane * 4], v1 * rr * gk[lane * 4 + 1]); o.y = cvt_pk_bf16(v2 * rr * gk[lane * 4 + 2], v3 * rr * gk[lane * 4 + 3]); *(u32x2*)p = o; }
                for (int it = gw2; it < 8 * 128; it += NGW2) { const int rg = it >> 7, ch = it & 127, r = rg * 64 + lane, bb = r >> 8, mm = r & 255;
                    const u32x4 w = *(const u32x4*)(KVM + (size_t)r * 2048 + 1024 + ch * 8); const int hh = ch >> 5, d0 = (ch & 31) * 8;
                    bf16_t* dst = VMT + ((size_t)(bb * 4 + hh) * 256 + d0) * 256 + mm;
                    dst[0] = (bf16_t)(w.x & 0xffffu); dst[256] = (bf16_t)(w.x >> 16); dst[512] = (bf16_t)(w.y & 0xffffu); dst[768] = (bf16_t)(w.y >> 16);
                    dst[1024] = (bf16_t)(w.z & 0xffffu); dst[1280] = (bf16_t)(w.z >> 16); dst[1536] = (bf16_t)(w.w & 0xffffu); dst[1792] = (bf16_t)(w.w >> 16); }
            }
            }
        }
        else if (kind == 6) {
            for (int prep_ = 0; prep_ < PROBE_CL2; ++prep_) for (int it = gw; it < 2048 * 2; it += NGW) { const int R = it >> 1, kv = it & 1, i = R >> 2, gg = R & 3;
                float acc = 0.f;
                if (R < 2044) {
                    const bf16_t* hr = HID + ((size_t)kv * 2048 + R) * 256; const u32x2 hw = *(const u32x2*)(hr + lane * 4);
                    const float h0 = bflo(hw.x), h1 = bfhi(hw.x), h2 = bflo(hw.y), h3 = bfhi(hw.y); const float* w2 = INP(kv ? I_W2V : I_W2K) + lane;
#pragma unroll 16
                    for (int jj = 0; jj < 64; ++jj) {
                        acc += __int_as_float(__builtin_amdgcn_readlane(__float_as_int(h0), jj)) * w2[(jj * 4 + 0) * 64];
                        acc += __int_as_float(__builtin_amdgcn_readlane(__float_as_int(h1), jj)) * w2[(jj * 4 + 1) * 64];
                        acc += __int_as_float(__builtin_amdgcn_readlane(__float_as_int(h2), jj)) * w2[(jj * 4 + 2) * 64];
                        acc += __int_as_float(__builtin_amdgcn_readlane(__float_as_int(h3), jj)) * w2[(jj * 4 + 3) * 64]; }
                }
                if (kv == 0) { const float rr = 1.0f / sqrtf(wave_sum(acc * acc) * (1.0f / 64.0f) + EPS); const float y = acc * rr * INP(I_GKC)[lane];
                    KC[((size_t)gg * 512 + i) * 64 + lane] = (bf16_t)(cvt_pk_bf16(y, 0.f) & 0xffffu); }
                else VCT[((size_t)gg * 64 + lane) * 512 + i] = (bf16_t)(cvt_pk_bf16(acc, 0.f) & 0xffffu);
            }
            for (int prep_ = 0; prep_ < PROBE_C2; ++prep_) for (int it = gw; it < (SEQ / 16) * 4; it += NGW) { const int hm = (it >> 3) & 3, t0 = ((((it >> 5) << 3) | (it & 7))) * 16;
                mem_task(ZMAIN, KVM + (size_t)b * 256 * 2048, VMT + (size_t)b * 4 * 256 * 256, hm, t0, lane, prep_ == PROBE_C2 - 1); }
        }
        else if (kind == 7) {
            for (int wt = cb; wt < (SEQ / 64) * 4; wt += G) { const int gg = wt & 3; int tl = wt >> 2;
                if (G == 256) { const int j = cb >> 2, r = wt >> 8; tl = r == 0 ? j : 127 - j; }
                const int T0 = tl * 64;
                const int ln_ = fresh_lane(); nsa_wg_task(ZMAIN, KC, VCT, VST, VWT, gg, T0, MF, lds, wave, ln_, (wave << 6) | ln_); }
        }
        else if (kind == 8) {
            pg8::Gemm g{ZMAIN, WBR_T, SEQ, 6144, 1024, ZM, 0, 1024}; pg8::Order S; S.init(SEQ, 6144, G, cb, 1);
            pg8::EpiMerge E{ZGATE, ZG, MF, H + boff * DM};
            for (int prep_ = 0; prep_ < PROBE_MERGE; ++prep_) pg8::gemm_phase<pg8::EpiMerge, pg8::Order, true, true>(lds, g, S, E, wave);
        }
        if (ph + 1 < ph_hi) for (int prep_ = 0; prep_ < PROBE_SYNC; ++prep_) { if (ph_hi > 1000) grid.sync(); else { XcdBarrier gb_; gb_.bar = (unsigned*)ldp(tab, 30); gb_.x = xb_xcc_id(); gb_.st = (volatile LAS unsigned*)(lds + 131072 + 512); xcd_barrier(gb_, wave == 0 && fresh_lane() == 0); } }
    }
}

#ifndef MK_MULTI
#define MK_MULTI 0
#endif
extern "C" void kernel_launch(void* const* d_in, const int* in_sizes, int n_in, void* d_out, int out_size, void* d_ws, size_t ws_size, hipStream_t stream) {
    static int grid = 0;
    if (grid == 0) {
        if (n_in != 29 || in_sizes[0] != MTOK * DM || out_size != MTOK * DM || ws_size < WS_END) { fprintf(stderr, "kernel_launch: unexpected shapes (n_in %d, in0 %d, out %d, ws %zu)\n", n_in, n_in > 0 ? in_sizes[0] : -1, out_size, ws_size); grid = -1; return; }
        int dev = 0, cus = 0, per_cu = 0;
        if (hipGetDevice(&dev) != hipSuccess || hipDeviceGetAttribute(&cus, hipDeviceAttributeMultiprocessorCount, dev) != hipSuccess) { grid = -1; return; }
        if (hipFuncSetAttribute((const void*)mega, hipFuncAttributeMaxDynamicSharedMemorySize, LDS_BYTES) != hipSuccess) { fprintf(stderr, "kernel_launch: hipFuncSetAttribute failed\n"); grid = -1; return; }
        if (hipOccupancyMaxActiveBlocksPerMultiprocessor(&per_cu, (const void*)mega, 512, LDS_BYTES) != hipSuccess || per_cu < 1) { fprintf(stderr, "kernel_launch: occupancy query gives %d\n", per_cu); per_cu = 1; }
        (void)hipGetLastError();
        grid = cus * per_cu;
    }
    if (grid < 0) return;
    Args a{};
    for (int i = 0; i < 29; ++i) a.in[i] = (const float*)d_in[i];
    a.out = (float*)d_out; a.ws = (unsigned char*)d_ws;
#if MK_MULTI
    for (int ph = 0; ph < NPHASE; ++ph) { a.ph_lo = ph; a.ph_hi = ph + 1; hipLaunchKernelGGL(mega, dim3(grid), dim3(512), LDS_BYTES, stream, a); }
#else
    a.ph_lo = 0; a.ph_hi = NPHASE;
    if (hipMemsetAsync(d_ws, 0, 16384, stream) != hipSuccess) { fprintf(stderr, "kernel_launch: hipMemsetAsync failed\n"); return; }
    void* args[] = {&a};
    const hipError_t e = hipLaunchCooperativeKernel((const void*)mega, dim3(grid), dim3(512), args, LDS_BYTES, stream);
    if (e != hipSuccess) fprintf(stderr, "kernel_launch: cooperative launch failed: %s (grid %d)\n", hipGetErrorString(e), grid);
#endif
}
```
